# Optimizing an MI355X kernel written in HIP

```python
import jax, jax.numpy as jnp
from jax import lax
import numpy as np

D_MODEL = 2048
BATCH = 4
SEQ = 4096
DEPTH = 4

N_A = DEPTH // 2
N_B = DEPTH - N_A
RET_DIM = 256
RET_HEADS = D_MODEL // RET_DIM
RET_WIDTH = RET_HEADS * RET_DIM
RET_CHUNK = 128
RET_THETA = 10000.0
SWA_DIM = 64
SWA_HEADS = D_MODEL // SWA_DIM
SWA_KV_HEADS = SWA_HEADS // 8
SWA_WIDTH = SWA_HEADS * SWA_DIM
SWA_KV_WIDTH = SWA_KV_HEADS * SWA_DIM
WINDOW = 128
ROPE_THETA = 500000.0
ROT_DIM = SWA_DIM // 4
MEM_TOKENS = 256
MEM_HEADS = 4
MEM_DIM = D_MODEL // 8
MEM_WIDTH = MEM_HEADS * MEM_DIM
IN_A = 4 * RET_WIDTH + 2 * MEM_WIDTH
IN_B = 2 * SWA_WIDTH + 2 * MEM_WIDTH
MIX_WIDTH = RET_WIDTH + MEM_WIDTH
EPS = 1e-6

kernel_name = "yoco_retention_swa_sinks_memxattn"


def rms_norm(x, g):
    xf = x.astype(jnp.float32)
    y = xf * lax.rsqrt(jnp.mean(xf * xf, axis=-1, keepdims=True) + EPS)
    return (y * g.astype(jnp.float32)).astype(x.dtype)


def head_rms(x):
    xf = x.astype(jnp.float32)
    return xf * lax.rsqrt(jnp.mean(xf * xf, axis=-1, keepdims=True) + EPS)


def rope(x, positions, rot_dim, theta):
    inv = theta ** (-jnp.arange(0, rot_dim, 2, dtype=jnp.float32) / rot_dim)
    ang = positions.astype(jnp.float32)[..., None] * inv
    cos = jnp.cos(ang)[:, :, None, :].astype(x.dtype)
    sin = jnp.sin(ang)[:, :, None, :].astype(x.dtype)
    half = rot_dim // 2
    x1, x2, rest = x[..., :half], x[..., half:rot_dim], x[..., rot_dim:]
    return jnp.concatenate([x1 * cos - x2 * sin, x2 * cos + x1 * sin, rest], axis=-1)


def retention_chunkwise(q, k, v):
    B, S, H, dk = q.shape
    dv = v.shape[-1]
    C = RET_CHUNK
    N = S // C
    f32 = jnp.float32
    log_gamma = jnp.log(1.0 - jnp.exp2(-5.0 - jnp.arange(H, dtype=f32)))

    def to_chunks(t):
        return t.astype(f32).reshape(B, N, C, H, t.shape[-1]).transpose(1, 0, 3, 2, 4)

    qc, kc, vc = to_chunks(q), to_chunks(k), to_chunks(v)
    idx = jnp.arange(C, dtype=f32)
    diff = idx[:, None] - idx[None, :]
    decay = jnp.where(diff[None] >= 0,
                      jnp.exp(log_gamma[:, None, None] * jnp.maximum(diff, 0.0)[None]), 0.0)
    xi = jnp.exp(log_gamma[:, None] * (idx + 1.0))[:, :, None]
    zeta = jnp.exp(log_gamma[:, None] * (C - 1.0 - idx))[:, :, None]
    g_chunk = jnp.exp(log_gamma * C)[:, None, None]

    def step(R, inp):
        q_, k_, v_ = inp
        inner = jnp.einsum('bhnd,bhmd->bhnm', q_, k_) * decay
        o = (jnp.einsum('bhnm,bhmv->bhnv', inner, v_)
             + jnp.einsum('bhnd,bhdv->bhnv', q_ * xi, R))
        R = R * g_chunk + jnp.einsum('bhmd,bhmv->bhdv', k_ * zeta, v_)
        return R, o

    R0 = jnp.zeros((B, H, dk, dv), f32)
    _, o = lax.scan(step, R0, (qc, kc, vc))
    return o.transpose(1, 0, 3, 2, 4).reshape(B, S, H, dv)


def swa_sinks(q, k, v, sinks):
    B, S, Hq, d = q.shape
    Hkv = k.shape[2]
    G = Hq // Hkv
    W = WINDOW
    N = S // W
    qb = q.reshape(B, N, W, Hkv, G, d)
    kb = k.reshape(B, N, W, Hkv, d)
    vb = v.reshape(B, N, W, Hkv, d)
    zeros = jnp.zeros_like(kb[:, :1])
    kk = jnp.concatenate([jnp.concatenate([zeros, kb[:, :-1]], axis=1), kb], axis=2)
    vv = jnp.concatenate([jnp.concatenate([zeros, vb[:, :-1]], axis=1), vb], axis=2)
    s = jnp.einsum('bnqkgd,bnjkd->bnkgqj', qb, kk).astype(jnp.float32) * (d ** -0.5)
    qi = jnp.arange(W)[:, None] + W
    kj = jnp.arange(2 * W)[None, :]
    rel = qi - kj
    band = (rel >= 0) & (rel < W)
    not_pad = (jnp.arange(N)[:, None, None] > 0) | (kj[None] >= W)
    mask = band[None] & not_pad
    s = jnp.where(mask[None, :, None, None], s, -1e30)
    sink = sinks.astype(jnp.float32).reshape(1, 1, Hkv, G, 1, 1)
    m = jnp.maximum(jnp.max(s, axis=-1, keepdims=True), sink)
    p = jnp.exp(s - m)
    denom = jnp.sum(p, axis=-1, keepdims=True) + jnp.exp(sink - m)
    p = (p / denom).astype(v.dtype)
    o = jnp.einsum('bnkgqj,bnjkd->bnqkgd', p, vv)
    return o.reshape(B, S, Hq * d)


def mem_attention(qm, mk, mv):
    s = jnp.einsum('bshd,bmhd->bhsm', qm, mk).astype(jnp.float32) * (qm.shape[-1] ** -0.5)
    p = jax.nn.softmax(s, axis=-1).astype(mv.dtype)
    o = jnp.einsum('bhsm,bmhd->bshd', p, mv)
    return o.reshape(qm.shape[0], qm.shape[1], -1)


def setup_inputs(seed: int = 0) -> dict:
    key = jax.random.key(seed)
    ks = jax.random.split(key, 14)
    f32 = jnp.float32

    def w(k, shape, fan_in):
        return jax.random.normal(k, shape, f32) * (fan_in ** -0.5)

    x = jax.random.normal(ks[0], (BATCH, SEQ, D_MODEL), f32)
    mem = jax.random.normal(ks[1], (BATCH, MEM_TOKENS, D_MODEL), f32)
    positions = (jax.random.randint(ks[2], (BATCH, 1), 0, 1024, dtype=jnp.int32)
                 + jnp.arange(SEQ, dtype=jnp.int32)[None, :])
    pre_norm_g = 1.0 + 0.05 * jax.random.normal(ks[3], (DEPTH, D_MODEL), f32)
    post_norm_g = 1.0 + 0.05 * jax.random.normal(ks[4], (DEPTH, D_MODEL), f32)
    mem_norm_g = 1.0 + 0.05 * jax.random.normal(ks[5], (DEPTH, D_MODEL), f32)
    kv_norm_g = 1.0 + 0.05 * jax.random.normal(ks[6], (D_MODEL,), f32)
    w_in_a = w(ks[7], (N_A, D_MODEL, IN_A), D_MODEL)
    w_in_b = w(ks[8], (N_B, D_MODEL, IN_B), D_MODEL)
    w_kv_b = w(ks[9], (D_MODEL, 2 * SWA_KV_WIDTH), D_MODEL)
    sinks_b = 0.5 * jax.random.normal(ks[10], (N_B, SWA_HEADS), f32)
    w_mem_kv = w(ks[11], (DEPTH, D_MODEL, 2 * MEM_WIDTH), D_MODEL)
    w_out = w(ks[12], (DEPTH, MIX_WIDTH, D_MODEL), MIX_WIDTH)
    return {"x": x, "mem": mem, "positions": positions,
            "pre_norm_g": pre_norm_g, "post_norm_g": post_norm_g,
            "mem_norm_g": mem_norm_g, "kv_norm_g": kv_norm_g,
            "w_in_a": w_in_a, "w_in_b": w_in_b, "w_kv_b": w_kv_b,
            "sinks_b": sinks_b, "w_mem_kv": w_mem_kv, "w_out": w_out}


def reference(x, mem, positions, pre_norm_g, post_norm_g, mem_norm_g, kv_norm_g,
              w_in_a, w_in_b, w_kv_b, sinks_b, w_mem_kv, w_out):
    B, S, _ = x.shape
    M = mem.shape[1]
    h = x
    k_shared = None
    v_shared = None
    for l in range(DEPTH):
        y = rms_norm(h, pre_norm_g[l])
        mkv = rms_norm(mem, mem_norm_g[l]) @ w_mem_kv[l]
        mk = mkv[..., :MEM_WIDTH].reshape(B, M, MEM_HEADS, MEM_DIM)
        mv = mkv[..., MEM_WIDTH:].reshape(B, M, MEM_HEADS, MEM_DIM)
        if l < N_A:
            z = y @ w_in_a[l]
            q, k, v, g, qm, gm = jnp.split(
                z, np.cumsum([RET_WIDTH] * 4 + [MEM_WIDTH]).tolist(), axis=-1)
            q = rope(q.reshape(B, S, RET_HEADS, RET_DIM), positions, RET_DIM, RET_THETA)
            k = rope(k.reshape(B, S, RET_HEADS, RET_DIM), positions, RET_DIM, RET_THETA) * (RET_DIM ** -0.5)
            v = v.reshape(B, S, RET_HEADS, RET_DIM)
            o_main = head_rms(retention_chunkwise(q, k, v)).astype(x.dtype).reshape(B, S, RET_WIDTH)
        else:
            z = y @ w_in_b[l - N_A]
            q, g, qm, gm = jnp.split(
                z, np.cumsum([SWA_WIDTH, SWA_WIDTH, MEM_WIDTH]).tolist(), axis=-1)
            q = rope(q.reshape(B, S, SWA_HEADS, SWA_DIM), positions, ROT_DIM, ROPE_THETA)
            o_main = swa_sinks(q, k_shared, v_shared, sinks_b[l - N_A])
        o_main = o_main * jax.nn.silu(g)
        o_mem = mem_attention(qm.reshape(B, S, MEM_HEADS, MEM_DIM), mk, mv) * jax.nn.silu(gm)
        out = jnp.concatenate([o_main, o_mem], axis=-1) @ w_out[l]
        h = h + rms_norm(out, post_norm_g[l])
        if l == N_A - 1:
            kv = rms_norm(h, kv_norm_g) @ w_kv_b
            k_shared = rope(kv[..., :SWA_KV_WIDTH].reshape(B, S, SWA_KV_HEADS, SWA_DIM),
                            positions, ROT_DIM, ROPE_THETA)
            v_shared = kv[..., SWA_KV_WIDTH:].reshape(B, S, SWA_KV_HEADS, SWA_DIM)
    return h
```

```cpp
#include <hip/hip_runtime.h>
#include <hip/hip_cooperative_groups.h>
#include <cstdio>
#include <cstdint>
#include <cmath>
namespace cg = cooperative_groups;

#ifndef MK_SINGLE
#define MK_SINGLE 1
#endif

#ifndef EN_MASK
#define EN_MASK 0xFFFF
#endif
#define EN(b) ((EN_MASK >> (b)) & 1)
#define LAS __attribute__((address_space(3)))
typedef unsigned short bf16_t;
typedef short bf16x8 __attribute__((ext_vector_type(8)));
typedef float f32x4 __attribute__((ext_vector_type(4)));
typedef float f32x2 __attribute__((ext_vector_type(2)));
typedef unsigned u32x4 __attribute__((ext_vector_type(4)));
typedef unsigned u32x2 __attribute__((ext_vector_type(2)));

constexpr int T = 16384, D = 2048, SEQ = 4096;
constexpr float EPS = 1e-6f;
constexpr int NTHREADS = 512, NWAVES = 8;

constexpr size_t MiB = 1u << 20;
constexpr size_t WS_TABN = 1 * MiB;
constexpr size_t WS_COST = 17 * MiB;
constexpr size_t WS_SINT = 25 * MiB;
constexpr size_t WS_KS   = 1 * MiB;
constexpr size_t WS_VST  = 9 * MiB;
constexpr size_t WS_SWAT = 33 * MiB;
constexpr size_t WS_MEMN = 34 * MiB;
constexpr size_t WS_MK   = 38 * MiB;
constexpr size_t WS_MVT  = 46 * MiB;
constexpr size_t WS_WNAT = 54 * MiB;
constexpr size_t WS_WSWP = 86 * MiB;
constexpr size_t WS_WOUT = 102 * MiB;
constexpr size_t WS_Z    = 114 * MiB;
constexpr size_t WS_KVT  = 370 * MiB;
constexpr size_t WS_OUTF = 370 * MiB;
constexpr size_t WS_RT   = 498 * MiB;
constexpr size_t WS_YN   = 498 * MiB;
constexpr size_t WS_WMK  = 562 * MiB;
constexpr size_t WS_WMV  = 578 * MiB;
constexpr size_t WS_END  = 626 * MiB;

constexpr int LDS_BYTES = 147456 + 64;
constexpr int REG_B = 73728;

struct Params {
    const float* x; const float* mem; const int* pos; const float* pre_g; const float* post_g; const float* mem_g; const float* kv_g;
    const float* w_in_a; const float* w_in_b; const float* w_kv_b; const float* sinks; const float* w_mem_kv; const float* w_out;
    float* out; unsigned char* ws; int ph_lo, ph_hi;
    float inv_ret[128]; float inv_swa[8];
};

namespace pg8 {
constexpr int BM = 256, BK = 64, HALF = 128, HTB = HALF * BK * 2, STAGE_BYTES = 8 * HTB, NXCD = 8, WGM = 8;
__host__ __device__ __forceinline__ int lds_byte(int r, int c) { const int st = (r >> 4) * 2 + (c >> 5), rr = r & 15, cc = c & 31, ob = rr * 64 + cc * 2; return st * 1024 + (ob ^ (((ob >> 9) & 1) << 5)); }
__host__ __device__ __forceinline__ void stage_rc(int b, int& R, int& C) { const int st = b / 1024, sb = b % 1024, swz = sb ^ (((sb >> 9) & 1) << 5); R = (st >> 1) * 16 + swz / 64; C = (st & 1) * 32 + (swz % 64) / 2; }
__host__ __device__ __forceinline__ int perm32(int rho) { const int n = rho >> 4, i = rho & 15; return 8 * (i >> 2) + 4 * n + (i & 3); }

struct Unit { int pm, pn; };
struct Gemm { const bf16_t* A; const bf16_t* Bt; int M, N, K, lda, ldb; };

struct StaticOrder {
    int nM, nN, nwg, G, c;
    __host__ __device__ void init(int M, int N, int G_, int c_) { nM = M / BM; nN = N / BM; nwg = nM * nN; G = G_; c = c_; }
    __host__ __device__ bool next(int i, Unit& u) const {
        const long L = (long)i * G + c; if (L >= nwg) return false;
        int wgid = (int)L; { const int q = nwg / NXCD, r = nwg % NXCD, xcd = wgid % NXCD, off = wgid / NXCD; wgid = (xcd < r ? xcd * (q + 1) : r * (q + 1) + (xcd - r) * q) + off; }
        const int nig = WGM * nN, gid = wgid / nig, fm = gid * WGM, gsz = (nM - fm) < WGM ? (nM - fm) : WGM;
        u.pm = fm + ((wgid % nig) % gsz); u.pn = (wgid % nig) / gsz; return true;
    }
};

typedef _Float16 f16x2_t __attribute__((ext_vector_type(2)));
typedef _Float16 f16x8_t __attribute__((ext_vector_type(8)));
__device__ __forceinline__ unsigned cvt_pk_bf16(float lo, float hi) { const f16x2_t v = {(_Float16)lo, (_Float16)hi}; return __builtin_bit_cast(unsigned, v); }

template <class Epi, bool ALIGN_EPI>
__device__ __forceinline__ void gemm_phase(LAS unsigned char* lds, const Gemm g_in, const StaticOrder& S, const Epi& E) {
    Gemm g = g_in;
    { const bf16_t* a_ = g.A; const bf16_t* b_ = g.Bt; asm volatile("" : "+s"(a_), "+s"(b_)); g.A = a_; g.Bt = b_; }
    int tid = threadIdx.x; asm volatile("" : "+v"(tid));
    const int wid = __builtin_amdgcn_readfirstlane(tid >> 6), lane = tid & 63, wr = wid >> 2, wc = wid & 3, fr = lane & 15, fq = lane >> 4;
    const int K = g.K, nt = K / BK;
    unsigned voffA[2], voffB[2];
#pragma unroll
    for (int i = 0; i < 2; ++i) { int R, C; stage_rc(tid * 16 + i * 8192, R, C); const int Rb = Epi::PERM ? ((R & ~31) + perm32(R & 31)) : R;
        voffA[i] = (unsigned)(R * g.lda + C) * 2u; voffB[i] = (unsigned)(Rb * g.ldb + C) * 2u; }
    const size_t kstep = (size_t)(BK * 2);
    const size_t hstepA = (size_t)HALF * g.lda * 2, hstepB = (size_t)HALF * g.ldb * 2;
    const size_t tstepA = 2 * hstepA, tstepB = 2 * hstepB;
    const unsigned ldsw = (unsigned)wid * 1024u;
    const int aoff = lds_byte(wr * 64 + fr, fq * 8), boff = lds_byte(wc * 32 + fr, fq * 8);
#define PG8_SA(b, h) (((b) * 2 + (h)) * HTB)
#define PG8_SB(b, h) ((4 + (b) * 2 + (h)) * HTB)
#define PG8_STAGE(bufoff, gbase, voff) do { _Pragma("unroll") for (int _i = 0; _i < 2; ++_i) \
        __builtin_amdgcn_global_load_lds((const unsigned*)((const char*)(gbase) + (voff)[_i]), (LAS unsigned*)(lds + (bufoff) + ldsw + _i * 8192), 16, 0, 0); } while (0)
#define PG8_LDA(dst, b, h) do { _Pragma("unroll") for (int m = 0; m < 4; ++m) _Pragma("unroll") for (int k = 0; k < 2; ++k) dst[m][k] = *(const LAS bf16x8*)(lds + PG8_SA(b, h) + aoff + m * 2048 + k * 1024); } while (0)
#define PG8_LDB(dst, b, h) do { _Pragma("unroll") for (int n = 0; n < 2; ++n) _Pragma("unroll") for (int k = 0; k < 2; ++k) dst[n][k] = *(const LAS bf16x8*)(lds + PG8_SB(b, h) + boff + n * 2048 + k * 1024); } while (0)
#define PG8_MMA(ai, bj, At, Bt) do { __builtin_amdgcn_s_setprio(1); _Pragma("unroll") for (int m = 0; m < 4; ++m) _Pragma("unroll") for (int n = 0; n < 2; ++n) _Pragma("unroll") for (int k = 0; k < 2; ++k) \
        acc[ai][bj][m][n] = __builtin_amdgcn_mfma_f32_16x16x32_f16(__builtin_bit_cast(f16x8_t, Bt[n][k]), __builtin_bit_cast(f16x8_t, At[m][k]), acc[ai][bj][m][n], 0, 0, 0); __builtin_amdgcn_s_setprio(0); } while (0)
#define PG8_WAIT_V(n) asm volatile("s_waitcnt vmcnt(" #n ")" ::: "memory")
#define PG8_WAIT_L(n) asm volatile("s_waitcnt lgkmcnt(" #n ")" ::: "memory")
#define PG8_BAR __builtin_amdgcn_s_barrier()
#define PG8_SCHED __builtin_amdgcn_sched_barrier(0)
    Unit cur, nxt; int ui = 0;
    if (!S.next(0, cur)) return;
    f32x4 acc[2][2][4][2];
#pragma unroll
    for (int a = 0; a < 2; ++a)
#pragma unroll
        for (int b = 0; b < 2; ++b)
#pragma unroll
            for (int m = 0; m < 4; ++m)
#pragma unroll
                for (int n = 0; n < 2; ++n) acc[a][b][m][n] = (f32x4){0.f, 0.f, 0.f, 0.f};
    bf16x8 At[4][2], B0[2][2], B1[2][2];
    const char* cA = (const char*)g.A + (size_t)cur.pm * tstepA; const char* cB = (const char*)g.Bt + (size_t)cur.pn * tstepB;
    PG8_STAGE(PG8_SB(0, 0), cB, voffB); PG8_STAGE(PG8_SB(0, 1), cB + hstepB, voffB); PG8_STAGE(PG8_SA(0, 0), cA, voffA); PG8_STAGE(PG8_SA(0, 1), cA + hstepA, voffA);
    if (wr == 1) PG8_BAR;
    PG8_WAIT_V(2); PG8_BAR;
    PG8_STAGE(PG8_SB(1, 0), cB + kstep, voffB); PG8_STAGE(PG8_SA(1, 0), cA + kstep, voffA); PG8_STAGE(PG8_SB(1, 1), cB + hstepB + kstep, voffB);
    PG8_WAIT_V(6); PG8_BAR;
    for (;;) {
        const bool has_next = S.next(ui + 1, nxt);
        const char* nA = has_next ? (const char*)g.A + (size_t)nxt.pm * tstepA : cA; const char* nB = has_next ? (const char*)g.Bt + (size_t)nxt.pn * tstepB : cB;
        for (int t = 0; t < nt; t += 2) {
            const bool last = (t == nt - 2);
            const char* a1 = cA + (size_t)(t + 1) * kstep;
            const char* a2 = last ? nA : cA + (size_t)(t + 2) * kstep; const char* b2 = last ? nB : cB + (size_t)(t + 2) * kstep;
            const char* a3 = a2 + kstep; const char* b3 = b2 + kstep;
            PG8_LDB(B0, 0, 0); PG8_LDB(B1, 0, 1); PG8_SCHED; PG8_LDA(At, 0, 0); PG8_STAGE(PG8_SA(1, 1), a1 + hstepA, voffA);
            PG8_WAIT_V(8); PG8_WAIT_L(0); PG8_BAR; PG8_MMA(0, 0, At, B0); PG8_MMA(0, 1, At, B1); PG8_BAR; PG8_SCHED;
            PG8_LDA(At, 0, 1); PG8_STAGE(PG8_SB(0, 0), b2, voffB); PG8_STAGE(PG8_SB(0, 1), b2 + hstepB, voffB); PG8_STAGE(PG8_SA(0, 0), a2, voffA);
            PG8_WAIT_V(8); PG8_WAIT_L(0); PG8_BAR; PG8_MMA(1, 0, At, B0); PG8_MMA(1, 1, At, B1); PG8_BAR; PG8_SCHED;
            PG8_LDB(B0, 1, 0); PG8_LDB(B1, 1, 1); PG8_SCHED; PG8_LDA(At, 1, 0); PG8_STAGE(PG8_SA(0, 1), a2 + hstepA, voffA);
            PG8_WAIT_V(8); PG8_WAIT_L(0); PG8_BAR; PG8_MMA(0, 0, At, B0); PG8_MMA(0, 1, At, B1); PG8_BAR; PG8_SCHED;
            PG8_LDA(At, 1, 1); PG8_STAGE(PG8_SB(1, 0), b3, voffB); PG8_STAGE(PG8_SB(1, 1), b3 + hstepB, voffB); PG8_STAGE(PG8_SA(1, 0), a3, voffA);
            PG8_WAIT_V(8); PG8_WAIT_L(0); PG8_BAR; PG8_MMA(1, 0, At, B0); PG8_MMA(1, 1, At, B1); PG8_BAR; PG8_SCHED;
        }
        if constexpr (ALIGN_EPI) { if (wr == 0) PG8_BAR; }
        { int fr_ = fr, fq_ = fq; asm volatile("" : "+v"(fr_), "+v"(fq_)); E(acc, cur, wr, wc, fr_, fq_); }
        if (!has_next) break;
#pragma unroll
        for (int a = 0; a < 2; ++a)
#pragma unroll
            for (int b = 0; b < 2; ++b)
#pragma unroll
                for (int m = 0; m < 4; ++m)
#pragma unroll
                    for (int n = 0; n < 2; ++n) acc[a][b][m][n] = (f32x4){0.f, 0.f, 0.f, 0.f};
        cur = nxt; cA = nA; cB = nB; ++ui;
        if constexpr (ALIGN_EPI) { if (wr == 1) PG8_BAR; }
    }
    PG8_WAIT_V(0);
    if constexpr (!ALIGN_EPI) { if (wr == 0) PG8_BAR; }
    PG8_BAR;
#undef PG8_SA
#undef PG8_SB
#undef PG8_STAGE
#undef PG8_LDA
#undef PG8_LDB
#undef PG8_MMA
#undef PG8_WAIT_V
#undef PG8_WAIT_L
#undef PG8_BAR
#undef PG8_SCHED
}
}
using pg8::cvt_pk_bf16;

__device__ __forceinline__ float shx(float v, int mask, int lane) { return __int_as_float(__builtin_amdgcn_ds_bpermute((lane ^ mask) << 2, __float_as_int(v))); }
__device__ __forceinline__ u32x4 pack8(const f32x4 a, const f32x4 b) { u32x4 w; w.x = cvt_pk_bf16(a[0], a[1]); w.y = cvt_pk_bf16(a[2], a[3]); w.z = cvt_pk_bf16(b[0], b[1]); w.w = cvt_pk_bf16(b[2], b[3]); return w; }

struct EpiNat {
    static constexpr bool PERM = true;
    bf16_t* O; int ldc; int rope_tiles; const f32x4* tabN; int swa_tiles; int kred_pn; bf16_t* KS; const f32x4* swaTab;
    __device__ __forceinline__ void operator()(const f32x4 (&acc)[2][2][4][2], const pg8::Unit& u, int wr, int wc, int fr, int fq) const {
        const int row0 = u.pm * 256 + wr * 64 + fr; const int pn = u.pn;
        if (rope_tiles && (pn < 8 || (pn >= 16 && pn < 24))) {
            const float sc = pn < 8 ? 0.0625f : 1.f;
#pragma unroll
            for (int ai = 0; ai < 2; ++ai)
#pragma unroll
                for (int m = 0; m < 4; ++m) {
                    const int r = row0 + ai * 128 + m * 16;
                    const f32x4* tp = tabN + ((size_t)r * 128 + wc * 32 + fq * 8) / 2;
                    const f32x4 t0 = tp[0], t1 = tp[1], t2 = tp[2], t3 = tp[3];
                    f32x4 o1[2], o2[2];
#pragma unroll
                    for (int n = 0; n < 2; ++n) {
                        const f32x4 ta = n ? t2 : t0, tb = n ? t3 : t1;
                        const f32x4 c = (f32x4){ta[0], ta[2], tb[0], tb[2]}, s = (f32x4){ta[1], ta[3], tb[1], tb[3]};
                        const f32x4 x1 = acc[ai][0][m][n], x2 = acc[ai][1][m][n];
                        o1[n] = (x1 * c - x2 * s) * sc; o2[n] = (x2 * c + x1 * s) * sc;
                    }
                    bf16_t* rowp = O + (size_t)r * ldc + pn * 256 + wc * 32 + 8 * fq;
                    *(u32x4*)(rowp) = pack8(o1[0], o1[1]); *(u32x4*)(rowp + 128) = pack8(o2[0], o2[1]);
                    asm volatile("" ::: "memory");
                }
        } else if ((swa_tiles && pn >= 8 && pn < 16) || pn == kred_pn) {
            bf16_t* base = O; int ld = ldc; int colt = pn * 256;
            if (pn == kred_pn) { base = KS; ld = 256; colt = 0; }
            const bool rot = (wc & 1) == 0;
#pragma unroll
            for (int ai = 0; ai < 2; ++ai)
#pragma unroll
                for (int m = 0; m < 4; ++m) {
                    const int r = row0 + ai * 128 + m * 16;
                    f32x4 v[2][2];
#pragma unroll
                    for (int bj = 0; bj < 2; ++bj)
#pragma unroll
                        for (int n = 0; n < 2; ++n) v[bj][n] = acc[ai][bj][m][n];
                    if (rot) {
                        const f32x4* tp = swaTab + (size_t)r * 4;
                        const f32x4 t0 = tp[0], t1 = tp[1], t2 = tp[2], t3 = tp[3];
#pragma unroll
                        for (int n = 0; n < 2; ++n) {
                            const f32x4 ta = n ? t2 : t0, tb = n ? t3 : t1;
                            const f32x4 c = (f32x4){ta[0], ta[2], tb[0], tb[2]}, s = (f32x4){ta[1], ta[3], tb[1], tb[3]};
#pragma unroll
                            for (int bj = 0; bj < 2; ++bj) {
                                f32x4 x = v[bj][n], px;
#pragma unroll
                                for (int i = 0; i < 4; ++i) px[i] = shx(x[i], 16, fq * 16 + fr);
                                const f32x4 lo = x * c - px * s, hi = x * c + px * s;
                                v[bj][n] = fq == 0 ? lo : (fq == 1 ? hi : x);
                            }
                        }
                    }
                    bf16_t* rowp = base + (size_t)r * ld + colt + wc * 32 + 8 * fq;
                    *(u32x4*)(rowp) = pack8(v[0][0], v[0][1]); *(u32x4*)(rowp + 128) = pack8(v[1][0], v[1][1]);
                    asm volatile("" ::: "memory");
                }
        } else {
#pragma unroll
            for (int ai = 0; ai < 2; ++ai)
#pragma unroll
                for (int m = 0; m < 4; ++m) {
                    bf16_t* rowp = O + (size_t)(row0 + ai * 128 + m * 16) * ldc + pn * 256 + wc * 32 + 8 * fq;
                    *(u32x4*)(rowp) = pack8(acc[ai][0][m][0], acc[ai][0][m][1]); *(u32x4*)(rowp + 128) = pack8(acc[ai][1][m][0], acc[ai][1][m][1]);
                }
        }
    }
};

struct EpiSwp {
    static constexpr bool PERM = true;
    bf16_t* O; int ldc; int rope_row_tiles; const float* cosT; const float* sinT;
    __device__ __forceinline__ void operator()(const f32x4 (&acc)[2][2][4][2], const pg8::Unit& u, int wr, int wc, int fr, int fq) const {
        const int row0 = u.pm * 256 + wr * 64 + fr, col0 = u.pn * 256 + wc * 32 + 8 * fq;
        if (u.pm < rope_row_tiles) {
            const float lg = logf(1.f - exp2f(-5.f - (float)u.pm));
            f32x4 zeta[2];
#pragma unroll
            for (int n = 0; n < 2; ++n)
#pragma unroll
                for (int i = 0; i < 4; ++i) zeta[n][i] = expf(lg * (float)(127 - (wc * 32 + fq * 8 + n * 4 + i))) * 0.0625f;
#pragma unroll
            for (int m = 0; m < 4; ++m) {
                const int j = wr * 64 + m * 16 + fr;
#pragma unroll
                for (int bj = 0; bj < 2; ++bj) {
                    f32x4 o1[2], o2[2];
#pragma unroll
                    for (int n = 0; n < 2; ++n) {
                        const size_t to = (size_t)j * T + col0 + bj * 128 + n * 4;
                        const f32x4 c = *(const f32x4*)(cosT + to), s = *(const f32x4*)(sinT + to);
                        const f32x4 x1 = acc[0][bj][m][n], x2 = acc[1][bj][m][n];
                        o1[n] = (x1 * c - x2 * s) * zeta[n]; o2[n] = (x2 * c + x1 * s) * zeta[n];
                    }
                    bf16_t* p1 = O + (size_t)(row0 + m * 16) * ldc + col0 + bj * 128;
                    *(u32x4*)(p1) = pack8(o1[0], o1[1]); *(u32x4*)(p1 + (size_t)128 * ldc) = pack8(o2[0], o2[1]);
                    asm volatile("" ::: "memory");
                }
            }
        } else {
#pragma unroll
            for (int ai = 0; ai < 2; ++ai)
#pragma unroll
                for (int m = 0; m < 4; ++m) {
                    bf16_t* rowp = O + (size_t)(row0 + ai * 128 + m * 16) * ldc + col0;
                    *(u32x4*)(rowp) = pack8(acc[ai][0][m][0], acc[ai][0][m][1]); *(u32x4*)(rowp + 128) = pack8(acc[ai][1][m][0], acc[ai][1][m][1]);
                }
        }
    }
};

struct EpiF32 {
    static constexpr bool PERM = false;
    float* C; int ldc;
    __device__ __forceinline__ void operator()(const f32x4 (&acc)[2][2][4][2], const pg8::Unit& u, int wr, int wc, int fr, int fq) const {
        const int row0 = u.pm * 256 + wr * 64 + fr, col0 = u.pn * 256 + wc * 32 + 4 * fq;
#pragma unroll
        for (int ai = 0; ai < 2; ++ai)
#pragma unroll
            for (int m = 0; m < 4; ++m) { float* rowp = C + (size_t)(row0 + ai * 128 + m * 16) * ldc + col0;
#pragma unroll
                for (int bj = 0; bj < 2; ++bj)
#pragma unroll
                    for (int n = 0; n < 2; ++n) *(f32x4*)(rowp + bj * 128 + n * 16) = acc[ai][bj][m][n]; }
    }
};

__device__ __forceinline__ float wave_sum(float v, int lane) {
#pragma unroll
    for (int o = 1; o < 64; o <<= 1) v += shx(v, o, lane);
    return v;
}
__device__ __forceinline__ float bf2f(unsigned short b) { return (float)__builtin_bit_cast(_Float16, b); }
__device__ __forceinline__ float bflo(unsigned w) { return (float)__builtin_bit_cast(_Float16, (unsigned short)(w & 0xffffu)); }
__device__ __forceinline__ float bfhi(unsigned w) { return (float)__builtin_bit_cast(_Float16, (unsigned short)(w >> 16)); }
__device__ __forceinline__ unsigned short f2bf(float f) { return (unsigned short)(cvt_pk_bf16(f, 0.f) & 0xffffu); }
__device__ __forceinline__ f32x4 mfma16(bf16x8 a, bf16x8 b, f32x4 c) { return __builtin_amdgcn_mfma_f32_16x16x32_f16(__builtin_bit_cast(pg8::f16x8_t, a), __builtin_bit_cast(pg8::f16x8_t, b), c, 0, 0, 0); }
__device__ __forceinline__ bf16x8 ldg8(const bf16_t* p) { return *(const bf16x8*)p; }
__device__ __forceinline__ bf16x8 lds8(const LAS unsigned char* p) { return *(const LAS bf16x8*)p; }
__device__ __forceinline__ float silu(float g) { return g / (1.f + __expf(-g)); }
#define LDS_WAIT() asm volatile("s_waitcnt lgkmcnt(0)" ::: "memory")

template <int ROWS, int ROWB, int LP>
__device__ __forceinline__ void stage_tile(LAS unsigned char* dst, const unsigned char* src, size_t gpitch, int tid) {
    constexpr int CPR = ROWB / 16, TOTAL = ROWS * CPR, ITER = TOTAL / NTHREADS;
    static_assert(TOTAL % NTHREADS == 0, "stage_tile");
    constexpr int BATCH = ITER < 8 ? ITER : 8;
    static_assert(ITER % BATCH == 0, "stage_tile batch");
#pragma unroll
    for (int k0 = 0; k0 < ITER; k0 += BATCH) {
        u32x4 v[BATCH];
#pragma unroll
        for (int k = 0; k < BATCH; ++k) { const int c = tid + (k0 + k) * NTHREADS, r = c / CPR, cc = c % CPR; v[k] = *(const u32x4*)(src + (size_t)r * gpitch + cc * 16); }
#pragma unroll
        for (int k = 0; k < BATCH; ++k) { const int c = tid + (k0 + k) * NTHREADS, r = c / CPR, cc = c % CPR; *(LAS u32x4*)(dst + r * LP + cc * 16) = v[k]; }
        asm volatile("" ::: "memory");
    }
}

__device__ __forceinline__ u32x4 gate8(u32x4 o, u32x4 g) {
    u32x4 r;
#pragma unroll
    for (int k = 0; k < 4; ++k) r[k] = cvt_pk_bf16(bflo(o[k]) * silu(bflo(g[k])), bfhi(o[k]) * silu(bfhi(g[k])));
    return r;
}

__device__ __forceinline__ void sincos_f(float ang, float& c, float& s) {
    const double a = (double)ang, k = rint(a * 0.63661977236758134308);
    double r = fma(-k, 1.57079632679489661923, a); r = fma(-k, 6.123233995736766e-17, r);
    const double r2 = r * r;
    const double sn = r * (1.0 + r2 * (-1.0 / 6 + r2 * (1.0 / 120 + r2 * (-1.0 / 5040 + r2 * (1.0 / 362880 + r2 * (-1.0 / 39916800))))));
    const double cs = 1.0 + r2 * (-0.5 + r2 * (1.0 / 24 + r2 * (-1.0 / 720 + r2 * (1.0 / 40320 + r2 * (-1.0 / 3628800 + r2 * (1.0 / 479001600))))));
    const int q = ((int)k) & 3;
    const float fs = (float)sn, fc = (float)cs;
    c = (q == 0) ? fc : (q == 1) ? -fs : (q == 2) ? -fc : fs;
    s = (q == 0) ? fs : (q == 1) ? fc : (q == 2) ? -fs : -fc;
}

__device__ __forceinline__ void convert_block(const float* W, int ldw, int col0, int ncols, int K, const float* gain, bf16_t* WT, LAS float* scr, int gw, int NGW, int lane) {
    const int nblk = ncols / 32, items = (K / 64) * nblk;
    for (int it = gw; it < items; it += NGW) {
        const int kb = it / nblk, nb = it % nblk, k0 = 64 * kb, n0 = 32 * nb;
        const int c = lane & 7;
        f32x4 g0 = (f32x4){1.f, 1.f, 1.f, 1.f}, g1 = g0;
        if (gain) { g0 = *(const f32x4*)(gain + k0 + 8 * c); g1 = *(const f32x4*)(gain + k0 + 8 * c + 4); }
        const float* wp = W + (size_t)(k0 + (lane >> 5)) * ldw + col0 + n0 + (lane & 31);
        float v[32];
#pragma unroll
        for (int i = 0; i < 32; ++i) v[i] = wp[(size_t)(2 * i) * ldw];
#pragma unroll
        for (int i = 0; i < 32; ++i) scr[(2 * i + (lane >> 5)) * 33 + (lane & 31)] = v[i];
        LDS_WAIT();
#pragma unroll
        for (int j = 0; j < 4; ++j) { const int n = (lane >> 3) + 8 * j; const LAS float* s = scr + (8 * c) * 33 + n;
            u32x4 o; o.x = cvt_pk_bf16(s[0 * 33] * g0[0], s[1 * 33] * g0[1]); o.y = cvt_pk_bf16(s[2 * 33] * g0[2], s[3 * 33] * g0[3]);
            o.z = cvt_pk_bf16(s[4 * 33] * g1[0], s[5 * 33] * g1[1]); o.w = cvt_pk_bf16(s[6 * 33] * g1[2], s[7 * 33] * g1[3]);
            *(u32x4*)(WT + (size_t)(n0 + n) * K + k0 + 8 * c) = o; }
        LDS_WAIT();
    }
}

__device__ __forceinline__ void convert_layer(const Params& p, int l, LAS float* scr, int gw, int NGW, int lane) {
    int wz_ = 0; asm volatile("" : "+s"(wz_)); unsigned char* ws = p.ws + wz_;
    bf16_t* WNAT = (bf16_t*)(ws + WS_WNAT); bf16_t* WSWP = (bf16_t*)(ws + WS_WSWP); bf16_t* WOUT = (bf16_t*)(ws + WS_WOUT);
    const float* pg = p.pre_g + (size_t)l * D;
    if (l < 2) {
        const float* W = p.w_in_a + (size_t)l * D * 10240;
        convert_block(W, 10240, 2048, 2048, D, pg, WNAT, scr, gw, NGW, lane);
        convert_block(W, 10240, 6144, 2048, D, pg, WNAT + (size_t)2048 * D, scr, gw, NGW, lane);
        convert_block(W, 10240, 0, 2048, D, pg, WNAT + (size_t)4096 * D, scr, gw, NGW, lane);
        convert_block(W, 10240, 8192, 2048, D, pg, WNAT + (size_t)6144 * D, scr, gw, NGW, lane);
        convert_block(W, 10240, 4096, 2048, D, pg, WSWP + (size_t)2048 * D, scr, gw, NGW, lane);
    } else {
        const float* W = p.w_in_b + (size_t)(l - 2) * D * 6144;
        convert_block(W, 6144, 2048, 2048, D, pg, WNAT, scr, gw, NGW, lane);
        convert_block(W, 6144, 0, 2048, D, pg, WNAT + (size_t)2048 * D, scr, gw, NGW, lane);
        convert_block(W, 6144, 4096, 2048, D, pg, WNAT + (size_t)4096 * D, scr, gw, NGW, lane);
        if (l == 2) {
            convert_block(p.w_kv_b, 512, 0, 256, D, p.kv_g, WNAT + (size_t)6144 * D, scr, gw, NGW, lane);
            convert_block(p.w_kv_b, 512, 256, 256, D, p.kv_g, WSWP, scr, gw, NGW, lane);
        }
    }
    convert_block(p.w_out + (size_t)l * 3072 * D, D, 0, D, 3072, nullptr, WOUT, scr, gw, NGW, lane);
}

__device__ __forceinline__ void norm_row_bf16(const float* xrow, bf16_t* orow, int lane) {
    const f32x4* xr = (const f32x4*)xrow + lane;
    f32x4 v[8]; float s = 0.f;
#pragma unroll
    for (int j = 0; j < 8; ++j) { v[j] = xr[64 * j]; s += (v[j][0] * v[j][0] + v[j][1] * v[j][1]) + (v[j][2] * v[j][2] + v[j][3] * v[j][3]); }
    const float rs = rsqrtf(wave_sum(s, lane) * (1.f / D) + EPS);
    u32x2* o8 = (u32x2*)orow + lane;
#pragma unroll
    for (int j = 0; j < 8; ++j) { u32x2 w; w.x = cvt_pk_bf16(v[j][0] * rs, v[j][1] * rs); w.y = cvt_pk_bf16(v[j][2] * rs, v[j][3] * rs); o8[64 * j] = w; }
}

__device__ __forceinline__ void norm_row2_bf16(const float* xrow, bf16_t* orow, size_t stride, int lane) {
    f32x4 v[2][8]; float s[2] = {0.f, 0.f};
#pragma unroll
    for (int r = 0; r < 2; ++r) { const f32x4* xr = (const f32x4*)(xrow + r * stride) + lane;
#pragma unroll
        for (int j = 0; j < 8; ++j) v[r][j] = xr[64 * j]; }
#pragma unroll
    for (int r = 0; r < 2; ++r) {
#pragma unroll
        for (int j = 0; j < 8; ++j) s[r] += (v[r][j][0] * v[r][j][0] + v[r][j][1] * v[r][j][1]) + (v[r][j][2] * v[r][j][2] + v[r][j][3] * v[r][j][3]);
        const float rs = rsqrtf(wave_sum(s[r], lane) * (1.f / D) + EPS);
        u32x2* o8 = (u32x2*)(orow + r * stride) + lane;
#pragma unroll
        for (int j = 0; j < 8; ++j) { u32x2 w; w.x = cvt_pk_bf16(v[r][j][0] * rs, v[r][j][1] * rs); w.y = cvt_pk_bf16(v[r][j][2] * rs, v[r][j][3] * rs); o8[64 * j] = w; }
    }
}
__device__ __forceinline__ void phase_p0(const Params& p, LAS unsigned char* lds, int tid, int wave, int lane) {
    asm volatile("" : "+v"(lane), "+v"(tid));
    int wz_ = 0; asm volatile("" : "+s"(wz_)); unsigned char* ws = p.ws + wz_;
    const int G = gridDim.x, gw = blockIdx.x * NWAVES + wave, NGW = G * NWAVES;
    const size_t gt = (size_t)blockIdx.x * NTHREADS + tid, NT = (size_t)G * NTHREADS;
    f32x2* tabN = (f32x2*)(ws + WS_TABN); f32x2* swat = (f32x2*)(ws + WS_SWAT);
    for (size_t i = gt; i < (size_t)T * 128; i += NT) { const int tok = (int)(i >> 7), j = (int)(i & 127); float c, s; sincos_f((float)p.pos[tok] * p.inv_ret[j], c, s); tabN[i] = (f32x2){c, s}; }
    for (size_t i = gt; i < (size_t)T * 8; i += NT) { const int tok = (int)(i >> 3), j = (int)(i & 7); float c, s; sincos_f((float)p.pos[tok] * p.inv_swa[j], c, s); swat[i] = (f32x2){c, s}; }
    for (int m = gw; m < 1024; m += NGW) norm_row_bf16(p.mem + (size_t)m * D, (bf16_t*)(ws + WS_MEMN) + (size_t)m * D, lane);
    for (int m = gw; m < T; m += 2 * NGW) norm_row2_bf16(p.x + (size_t)m * D, (bf16_t*)(ws + WS_YN) + (size_t)m * D, (size_t)NGW * D, lane);
    LAS float* scr = (LAS float*)(lds + wave * 16384);
    for (int l = 0; l < 4; ++l) {
        convert_block(p.w_mem_kv + (size_t)l * D * 2048, 2048, 0, 1024, D, p.mem_g + (size_t)l * D, (bf16_t*)(ws + WS_WMK) + (size_t)l * 1024 * D, scr, gw, NGW, lane);
        convert_block(p.w_mem_kv + (size_t)l * D * 2048, 2048, 1024, 1024, D, p.mem_g + (size_t)l * D, (bf16_t*)(ws + WS_WMV) + (size_t)l * 1024 * D, scr, gw, NGW, lane);
    }
    convert_layer(p, 0, scr, gw, NGW, lane);
}

__device__ __forceinline__ void phase_norm(const Params& p, int l, LAS unsigned char* lds, int wave, int lane) {
    asm volatile("" : "+v"(lane));
    int wz_ = 0; asm volatile("" : "+s"(wz_)); unsigned char* ws = p.ws + wz_;
    const int gw = blockIdx.x * NWAVES + wave, NGW = gridDim.x * NWAVES;
    const bf16_t* OUTH = (const bf16_t*)(ws + WS_OUTF); bf16_t* YN = (bf16_t*)(ws + WS_YN);
    const float* hin = ((l == 0) ? p.x : p.out) + wz_; float* hout = p.out + wz_;
    f32x4 pg[8];
#pragma unroll
    for (int j = 0; j < 8; ++j) pg[j] = *((const f32x4*)(p.post_g + wz_ + (size_t)l * D) + lane + 64 * j);
    for (int m0 = gw; m0 < T; m0 += 2 * NGW) {
        f32x4 o[2][8], h[2][8];
#pragma unroll
        for (int r = 0; r < 2; ++r) { const int m = m0 + r * NGW;
            const u32x2* orow = (const u32x2*)(OUTH + (size_t)m * D) + lane; const f32x4* hrow = (const f32x4*)(hin + (size_t)m * D) + lane;
#pragma unroll
            for (int j = 0; j < 8; ++j) { const u32x2 ow = orow[64 * j]; o[r][j] = (f32x4){bflo(ow.x), bfhi(ow.x), bflo(ow.y), bfhi(ow.y)}; h[r][j] = hrow[64 * j]; } }
#pragma unroll
        for (int r = 0; r < 2; ++r) { const int m = m0 + r * NGW;
            float s = 0.f;
#pragma unroll
            for (int j = 0; j < 8; ++j) s += (o[r][j][0] * o[r][j][0] + o[r][j][1] * o[r][j][1]) + (o[r][j][2] * o[r][j][2] + o[r][j][3] * o[r][j][3]);
            const float rs = rsqrtf(wave_sum(s, lane) * (1.f / D) + EPS);
            float s2 = 0.f;
#pragma unroll
            for (int j = 0; j < 8; ++j) { h[r][j] = h[r][j] + o[r][j] * rs * pg[j]; s2 += (h[r][j][0] * h[r][j][0] + h[r][j][1] * h[r][j][1]) + (h[r][j][2] * h[r][j][2] + h[r][j][3] * h[r][j][3]); }
            f32x4* drow = (f32x4*)(hout + (size_t)m * D) + lane;
#pragma unroll
            for (int j = 0; j < 8; ++j) drow[64 * j] = h[r][j];
            if (l < 3) {
                const float rs2 = rsqrtf(wave_sum(s2, lane) * (1.f / D) + EPS);
                u32x2* o8 = (u32x2*)(YN + (size_t)m * D) + lane;
#pragma unroll
                for (int j = 0; j < 8; ++j) { u32x2 w; w.x = cvt_pk_bf16(h[r][j][0] * rs2, h[r][j][1] * rs2); w.y = cvt_pk_bf16(h[r][j][2] * rs2, h[r][j][3] * rs2); o8[64 * j] = w; }
            }
        }
    }
    if (l < 3) convert_layer(p, l + 1, (LAS float*)(lds + wave * 16384), gw, NGW, lane);
}

typedef short v4i16_t __attribute__((ext_vector_type(4)));
__device__ __forceinline__ unsigned mulh2(unsigned a, pg8::f16x2_t z) { const pg8::f16x2_t r = __builtin_bit_cast(pg8::f16x2_t, a) * z; return __builtin_bit_cast(unsigned, r); }
__device__ __forceinline__ v4i16_t lds_tr(const LAS unsigned char* p) { return __builtin_amdgcn_ds_read_tr16_b64_v4i16((LAS v4i16_t*)p); }
__device__ __forceinline__ void scan_unit(const bf16_t* Zk, const bf16_t* KVT, bf16_t* RT, LAS unsigned char* lds, int u, int wave, int lane) {
    asm volatile("" : "+v"(lane));
    const int b = u >> 6, h = (u >> 3) & 7, sl = u & 7, fr = lane & 15, fq = lane >> 4;
    const int dk0 = wave * 32, dv0 = sl * 32;
    const float lg = logf(1.f - exp2f(-5.f - (float)h));
    const float gch = expf(lg * 128.f);
    constexpr int KP = 80;
    const int krow = lane >> 2, kcc = lane & 3;
    const bf16_t* kbase = Zk + (size_t)(b * SEQ + krow) * 8192 + h * 256 + dk0 + kcc * 8;
    const bf16_t* vbase = KVT + (size_t)(2048 + h * 256 + dv0 + fr) * T + b * SEQ + fq * 8;
    bf16_t* rbase = RT + (size_t)((b * 8 + h) * 32) * 65536 + (size_t)(dv0 + fr) * 256 + dk0 + 4 * fq;
    LAS unsigned char* kl = lds + wave * (128 * KP);
    const int kst = krow * KP + kcc * 16;
    const int ktr = (8 * fq + (fr >> 2)) * KP + (fr & 3) * 8;
    pg8::f16x2_t zz[8];
#pragma unroll
    for (int k = 0; k < 8; ++k) { const _Float16 z = (_Float16)expf(lg * (float)(127 - (krow + 16 * k))); zz[k] = (pg8::f16x2_t){z, z}; }
    f32x4 acc[2][2];
#pragma unroll
    for (int a = 0; a < 2; ++a)
#pragma unroll
        for (int c = 0; c < 2; ++c) acc[a][c] = (f32x4){0.f, 0.f, 0.f, 0.f};
    u32x4 k0[8], k1[8]; bf16x8 b0[2][4], b1[2][4];
#define SC_LOAD(K_, B_, n_) do { _Pragma("unroll") for (int k_ = 0; k_ < 8; ++k_) K_[k_] = *(const u32x4*)(kbase + (size_t)((n_) * 128 + 16 * k_) * 8192); \
        _Pragma("unroll") for (int t_ = 0; t_ < 2; ++t_) _Pragma("unroll") for (int k_ = 0; k_ < 4; ++k_) B_[t_][k_] = ldg8(vbase + (size_t)(t_ * 16) * T + (n_) * 128 + k_ * 32); } while (0)
#define SC_STORE(n_) do { _Pragma("unroll") for (int mt_ = 0; mt_ < 2; ++mt_) _Pragma("unroll") for (int nt_ = 0; nt_ < 2; ++nt_) { u32x2 w_; \
        w_.x = cvt_pk_bf16(acc[mt_][nt_][0], acc[mt_][nt_][1]); w_.y = cvt_pk_bf16(acc[mt_][nt_][2], acc[mt_][nt_][3]); \
        *(u32x2*)(rbase + (size_t)(n_) * 65536 + nt_ * 16 * 256 + mt_ * 16) = w_; } } while (0)
#define SC_COMP(K_, B_) do { \
        _Pragma("unroll") for (int k_ = 0; k_ < 8; ++k_) { const u32x4 s_ = K_[k_]; u32x4 t_; t_.x = mulh2(s_.x, zz[k_]); t_.y = mulh2(s_.y, zz[k_]); t_.z = mulh2(s_.z, zz[k_]); t_.w = mulh2(s_.w, zz[k_]); \
            *(LAS u32x4*)(kl + kst + k_ * 16 * KP) = t_; } \
        LDS_WAIT(); \
        bf16x8 A_[2][4]; \
        _Pragma("unroll") for (int mt_ = 0; mt_ < 2; ++mt_) _Pragma("unroll") for (int k_ = 0; k_ < 4; ++k_) { \
            const v4i16_t lo_ = lds_tr(kl + ktr + (k_ * 32) * KP + mt_ * 32), hi_ = lds_tr(kl + ktr + (k_ * 32 + 4) * KP + mt_ * 32); \
            A_[mt_][k_] = (bf16x8){lo_.x, lo_.y, lo_.z, lo_.w, hi_.x, hi_.y, hi_.z, hi_.w}; } \
        LDS_WAIT(); \
        _Pragma("unroll") for (int mt_ = 0; mt_ < 2; ++mt_) _Pragma("unroll") for (int nt_ = 0; nt_ < 2; ++nt_) { acc[mt_][nt_] = acc[mt_][nt_] * gch; \
        _Pragma("unroll") for (int k_ = 0; k_ < 4; ++k_) acc[mt_][nt_] = mfma16(A_[mt_][k_], B_[nt_][k_], acc[mt_][nt_]); } } while (0)
    SC_LOAD(k0, b0, 0);
    for (int n = 0; n < 32; n += 2) {
        SC_STORE(n);
        if (n < 30) SC_LOAD(k1, b1, n + 1);
        SC_COMP(k0, b0);
        SC_STORE(n + 1);
        if (n < 30) { SC_LOAD(k0, b0, n + 2); SC_COMP(k1, b1); }
    }
#undef SC_LOAD
#undef SC_STORE
#undef SC_COMP
}

__device__ __forceinline__ void retc_unit(const Params& p, int u, LAS unsigned char* lds, int tid, int wave, int lane) {
    asm volatile("" : "+v"(lane), "+v"(tid));
    int wz_ = 0; asm volatile("" : "+s"(wz_)); unsigned char* ws = p.ws + wz_;
    bf16_t* Z = (bf16_t*)(ws + WS_Z); const bf16_t* KVT = (const bf16_t*)(ws + WS_KVT); const bf16_t* RT = (const bf16_t*)(ws + WS_RT);
    const int b = u >> 8, h = (u >> 5) & 7, n = u & 31, fr = lane & 15, fq = lane >> 4;
    const int tok0 = b * SEQ + n * 128, q0 = wave * 16;
    const float lg = logf(1.f - exp2f(-5.f - (float)h));
    LAS unsigned char* X = lds; LAS unsigned char* Y = lds + REG_B;
    bf16x8 qf[8];
#pragma unroll
    for (int ks = 0; ks < 8; ++ks) qf[ks] = ldg8(Z + (size_t)(tok0 + q0 + fr) * 8192 + 4096 + h * 256 + ks * 32 + fq * 8);
    const unsigned char* rt = (const unsigned char*)(RT + (size_t)((b * 8 + h) * 32 + n) * 65536);
    __syncthreads();
    stage_tile<128, 512, 544>(X, rt, 512, tid);
    stage_tile<128, 512, 544>(Y, rt + 128 * 512, 512, tid);
    __syncthreads();
    f32x4 acc[16];
#pragma unroll
    for (int nt = 0; nt < 16; ++nt) acc[nt] = (f32x4){0.f, 0.f, 0.f, 0.f};
#pragma unroll
    for (int nt = 0; nt < 16; ++nt) {
        const LAS unsigned char* rp = (nt < 8 ? X : Y) + ((nt & 7) * 16 + fr) * 544 + fq * 16;
#pragma unroll
        for (int ks = 0; ks < 8; ++ks) acc[nt] = mfma16(qf[ks], lds8(rp + ks * 64), acc[nt]);
    }
    {
        f32x4 xi;
#pragma unroll
        for (int i = 0; i < 4; ++i) xi[i] = expf(lg * (float)(q0 + 4 * fq + i + 1));
#pragma unroll
        for (int nt = 0; nt < 16; ++nt) acc[nt] = acc[nt] * xi;
    }
    __syncthreads();
    stage_tile<128, 512, 544>(X, (const unsigned char*)(Z + (size_t)tok0 * 8192 + h * 256), 8192 * 2, tid);
    stage_tile<256, 256, 288>(Y, (const unsigned char*)(KVT + (size_t)(2048 + h * 256) * T + tok0), (size_t)T * 2, tid);
    __syncthreads();
    f32x4 s[8];
#pragma unroll
    for (int nt = 0; nt < 8; ++nt) {
        s[nt] = (f32x4){0.f, 0.f, 0.f, 0.f};
        const LAS unsigned char* kp = X + (nt * 16 + fr) * 544 + fq * 16;
#pragma unroll
        for (int ks = 0; ks < 8; ++ks) s[nt] = mfma16(lds8(kp + ks * 64), qf[ks], s[nt]);
    }
    __syncthreads();
    LAS unsigned char* Pw = X + wave * 9216;
    {
        const float lg2 = lg * 1.4426950408889634f; const int qpos = q0 + fr;
#pragma unroll
        for (int nt = 0; nt < 8; ++nt) {
            f32x4 v;
#pragma unroll
            for (int i = 0; i < 4; ++i) { const int d = qpos - (nt * 16 + 4 * fq + i); v[i] = d >= 0 ? s[nt][i] * exp2f(lg2 * (float)d) : 0.f; }
            u32x2 w; w.x = cvt_pk_bf16(v[0], v[1]); w.y = cvt_pk_bf16(v[2], v[3]);
            *(LAS u32x2*)(Pw + fr * 288 + (nt * 16 + 4 * fq) * 2) = w;
        }
    }
    LDS_WAIT();
#pragma unroll
    for (int ks = 0; ks < 4; ++ks) {
        const bf16x8 pf = lds8(Pw + fr * 288 + ks * 64 + fq * 16);
#pragma unroll
        for (int nt = 0; nt < 16; ++nt) acc[nt] = mfma16(pf, lds8(Y + (nt * 16 + fr) * 288 + ks * 64 + fq * 16), acc[nt]);
    }
    u32x4 gvr[8];
#pragma unroll
    for (int k = 0; k < 8; ++k) { const int c = lane + 64 * k, row = c >> 5, cc = c & 31;
        gvr[k] = *(const u32x4*)(Z + (size_t)(tok0 + q0 + row) * 8192 + h * 256 + cc * 8 + 2048); }
    f32x4 ss = (f32x4){0.f, 0.f, 0.f, 0.f};
#pragma unroll
    for (int nt = 0; nt < 16; ++nt) ss = ss + acc[nt] * acc[nt];
#pragma unroll
    for (int o = 1; o < 16; o <<= 1)
#pragma unroll
        for (int i = 0; i < 4; ++i) ss[i] += shx(ss[i], o, lane);
    f32x4 rs;
#pragma unroll
    for (int i = 0; i < 4; ++i) rs[i] = rsqrtf(ss[i] * (1.f / 256.f) + EPS);
    LDS_WAIT();
#pragma unroll
    for (int nt = 0; nt < 16; ++nt)
#pragma unroll
        for (int i = 0; i < 4; ++i) *(LAS unsigned short*)(Pw + (4 * fq + i) * 544 + (nt * 16 + fr) * 2) = f2bf(acc[nt][i] * rs[i]);
    LDS_WAIT();
#pragma unroll
    for (int k = 0; k < 8; ++k) {
        const int c = lane + 64 * k, row = c >> 5, cc = c & 31;
        const u32x4 ov = *(const LAS u32x4*)(Pw + row * 544 + cc * 16);
        const size_t ro = (size_t)(tok0 + q0 + row) * 8192 + h * 256 + cc * 8;
        *(u32x4*)(Z + ro + 4096) = gate8(ov, gvr[k]);
    }
}

__device__ __forceinline__ void memattn_unit(const Params& p, int l, int u, int zld, int qcol0, LAS unsigned char* lds, int tid, int wave, int lane) {
    asm volatile("" : "+v"(lane), "+v"(tid));
    int wz_ = 0; asm volatile("" : "+s"(wz_)); unsigned char* ws = p.ws + wz_;
    bf16_t* Z = (bf16_t*)(ws + WS_Z); const bf16_t* MK = (const bf16_t*)(ws + WS_MK); const bf16_t* MVT = (const bf16_t*)(ws + WS_MVT);
    const int b = u >> 7, hm = (u >> 5) & 3, qb = u & 31, fr = lane & 15, fq = lane >> 4;
    const int tok0 = b * SEQ + qb * 128, q0 = wave * 16, qcol = qcol0 + hm * 256, gcol = qcol + 1024;
    LAS unsigned char* X = lds; LAS unsigned char* Y = lds + REG_B;
    bf16x8 qf[8];
#pragma unroll
    for (int ks = 0; ks < 8; ++ks) qf[ks] = ldg8(Z + (size_t)(tok0 + q0 + fr) * zld + qcol + ks * 32 + fq * 8);
    const unsigned char* mk = (const unsigned char*)(MK + (size_t)(b * 256) * 4096 + l * 1024 + hm * 256);
    const unsigned char* mv = (const unsigned char*)(MVT + (size_t)(l * 1024 + hm * 256) * 1024 + b * 256);
    __syncthreads();
    stage_tile<128, 512, 544>(X, mk, 4096 * 2, tid);
    stage_tile<128, 512, 544>(Y, mk + (size_t)128 * 4096 * 2, 4096 * 2, tid);
    __syncthreads();
    f32x4 s[16];
#pragma unroll
    for (int nt = 0; nt < 16; ++nt) {
        s[nt] = (f32x4){0.f, 0.f, 0.f, 0.f};
        const LAS unsigned char* kp = (nt < 8 ? X : Y) + ((nt & 7) * 16 + fr) * 544 + fq * 16;
#pragma unroll
        for (int ks = 0; ks < 8; ++ks) s[nt] = mfma16(lds8(kp + ks * 64), qf[ks], s[nt]);
    }
    float mx = -3.0e38f;
#pragma unroll
    for (int nt = 0; nt < 16; ++nt)
#pragma unroll
        for (int i = 0; i < 4; ++i) mx = fmaxf(mx, s[nt][i]);
    mx = fmaxf(mx, shx(mx, 16, lane)); mx = fmaxf(mx, shx(mx, 32, lane));
    float sum = 0.f;
#pragma unroll
    for (int nt = 0; nt < 16; ++nt)
#pragma unroll
        for (int i = 0; i < 4; ++i) { s[nt][i] = __expf((s[nt][i] - mx) * 0.0625f); sum += s[nt][i]; }
    sum += shx(sum, 16, lane); sum += shx(sum, 32, lane);
    const float inv = 1.f / sum;
    __syncthreads();
    LAS unsigned char* Pw = Y + wave * 9216;
#pragma unroll
    for (int nt = 0; nt < 16; ++nt) { u32x2 w; w.x = cvt_pk_bf16(s[nt][0] * inv, s[nt][1] * inv); w.y = cvt_pk_bf16(s[nt][2] * inv, s[nt][3] * inv);
        *(LAS u32x2*)(Pw + fr * 544 + (nt * 16 + 4 * fq) * 2) = w; }
    stage_tile<128, 512, 544>(X, mv, 1024 * 2, tid);
    __syncthreads();
    f32x4 acc[16];
#pragma unroll
    for (int nt = 0; nt < 16; ++nt) acc[nt] = (f32x4){0.f, 0.f, 0.f, 0.f};
#pragma unroll
    for (int ks = 0; ks < 8; ++ks) {
        const bf16x8 pf = lds8(Pw + fr * 544 + ks * 64 + fq * 16);
#pragma unroll
        for (int nt = 0; nt < 8; ++nt) acc[nt] = mfma16(pf, lds8(X + (nt * 16 + fr) * 544 + ks * 64 + fq * 16), acc[nt]);
    }
    __syncthreads();
    stage_tile<128, 512, 544>(X, mv + (size_t)128 * 1024 * 2, 1024 * 2, tid);
    __syncthreads();
#pragma unroll
    for (int ks = 0; ks < 8; ++ks) {
        const bf16x8 pf = lds8(Pw + fr * 544 + ks * 64 + fq * 16);
#pragma unroll
        for (int nt = 0; nt < 8; ++nt) acc[8 + nt] = mfma16(pf, lds8(X + (nt * 16 + fr) * 544 + ks * 64 + fq * 16), acc[8 + nt]);
    }
    u32x4 gvm[8];
#pragma unroll
    for (int k = 0; k < 8; ++k) { const int c = lane + 64 * k, row = c >> 5, cc = c & 31;
        gvm[k] = *(const u32x4*)(Z + (size_t)(tok0 + q0 + row) * zld + gcol + cc * 8); }
    LDS_WAIT();
#pragma unroll
    for (int nt = 0; nt < 16; ++nt)
#pragma unroll
        for (int i = 0; i < 4; ++i) *(LAS unsigned short*)(Pw + (4 * fq + i) * 544 + (nt * 16 + fr) * 2) = f2bf(acc[nt][i]);
    LDS_WAIT();
#pragma unroll
    for (int k = 0; k < 8; ++k) {
        const int c = lane + 64 * k, row = c >> 5, cc = c & 31;
        const u32x4 ov = *(const LAS u32x4*)(Pw + row * 544 + cc * 16);
        const size_t ro = (size_t)(tok0 + q0 + row) * zld;
        *(u32x4*)(Z + ro + qcol + cc * 8) = gate8(ov, gvm[k]);
    }
}

__device__ __forceinline__ void swa_unit(const Params& p, int lb, int u, LAS unsigned char* lds, int tid, int wave, int lane) {
    asm volatile("" : "+v"(lane), "+v"(tid));
    int wz_ = 0; asm volatile("" : "+s"(wz_)); unsigned char* ws = p.ws + wz_;
    bf16_t* Z = (bf16_t*)(ws + WS_Z); const bf16_t* KS = (const bf16_t*)(ws + WS_KS); const bf16_t* VST = (const bf16_t*)(ws + WS_VST);
    const int b = u >> 7, kvh = (u >> 5) & 3, n = u & 31, fr = lane & 15, fq = lane >> 4;
    const int tok0 = b * SEQ + n * 128, hq = kvh * 8 + wave;
    const float sink = p.sinks[lb * 32 + hq];
    LAS unsigned char* X = lds; LAS unsigned char* Y = lds + 40960; LAS unsigned char* Pw = lds + 75776 + wave * 8704;
    __syncthreads();
    {
#pragma unroll
        for (int k = 0; k < 4; ++k) { const int c = tid + k * NTHREADS, r = c >> 3, cc = c & 7; u32x4 v = (u32x4){0u, 0u, 0u, 0u};
            if (n > 0 || r >= 128) v = *(const u32x4*)(KS + (size_t)(tok0 - 128 + r) * 256 + kvh * 64 + cc * 8);
            *(LAS u32x4*)(X + r * 160 + cc * 16) = v; }
#pragma unroll
        for (int k = 0; k < 4; ++k) { const int c = tid + k * NTHREADS, r = c >> 5, cc = c & 31; u32x4 v = (u32x4){0u, 0u, 0u, 0u};
            if (n > 0 || cc >= 16) v = *(const u32x4*)(VST + (size_t)(kvh * 64 + r) * T + tok0 - 128 + cc * 8);
            *(LAS u32x4*)(Y + r * 544 + cc * 16) = v; }
    }
    __syncthreads();
    for (int mt = 0; mt < 8; ++mt) {
        bf16x8 qf[2];
#pragma unroll
        for (int ks = 0; ks < 2; ++ks) qf[ks] = ldg8(Z + (size_t)(tok0 + mt * 16 + fr) * 6144 + 2048 + hq * 64 + ks * 32 + fq * 8);
        u32x4 gvs[2];
#pragma unroll
        for (int k = 0; k < 2; ++k) { const int c = lane + 64 * k, row = c >> 3, cc = c & 7; gvs[k] = *(const u32x4*)(Z + (size_t)(tok0 + mt * 16 + row) * 6144 + hq * 64 + cc * 8); }
        f32x4 s[16];
#pragma unroll
        for (int nt = 0; nt < 16; ++nt) {
            s[nt] = (f32x4){0.f, 0.f, 0.f, 0.f};
#pragma unroll
            for (int ks = 0; ks < 2; ++ks) s[nt] = mfma16(lds8(X + (nt * 16 + fr) * 160 + ks * 64 + fq * 16), qf[ks], s[nt]);
        }
        const int iq = mt * 16 + fr;
        float mx = -3.0e38f;
#pragma unroll
        for (int nt = 0; nt < 16; ++nt)
#pragma unroll
            for (int i = 0; i < 4; ++i) { const int jk = nt * 16 + 4 * fq + i, rel = iq + 128 - jk; const bool valid = rel >= 0 && rel < 128 && (n > 0 || jk >= 128);
                s[nt][i] = valid ? s[nt][i] * 0.125f : -1e30f; mx = fmaxf(mx, s[nt][i]); }
        mx = fmaxf(mx, shx(mx, 16, lane)); mx = fmaxf(mx, shx(mx, 32, lane));
        mx = fmaxf(mx, sink);
        float sum = 0.f;
#pragma unroll
        for (int nt = 0; nt < 16; ++nt)
#pragma unroll
            for (int i = 0; i < 4; ++i) { s[nt][i] = __expf(s[nt][i] - mx); sum += s[nt][i]; }
        sum += shx(sum, 16, lane); sum += shx(sum, 32, lane);
        const float inv = 1.f / (sum + __expf(sink - mx));
#pragma unroll
        for (int nt = 0; nt < 16; ++nt) { u32x2 w; w.x = cvt_pk_bf16(s[nt][0] * inv, s[nt][1] * inv); w.y = cvt_pk_bf16(s[nt][2] * inv, s[nt][3] * inv);
            *(LAS u32x2*)(Pw + fr * 544 + (nt * 16 + 4 * fq) * 2) = w; }
        LDS_WAIT();
        f32x4 acc[4];
#pragma unroll
        for (int nt = 0; nt < 4; ++nt) acc[nt] = (f32x4){0.f, 0.f, 0.f, 0.f};
#pragma unroll
        for (int ks = 0; ks < 8; ++ks) {
            const bf16x8 pf = lds8(Pw + fr * 544 + ks * 64 + fq * 16);
#pragma unroll
            for (int nt = 0; nt < 4; ++nt) acc[nt] = mfma16(pf, lds8(Y + (nt * 16 + fr) * 544 + ks * 64 + fq * 16), acc[nt]);
        }
        LDS_WAIT();
#pragma unroll
        for (int nt = 0; nt < 4; ++nt)
#pragma unroll
            for (int i = 0; i < 4; ++i) *(LAS unsigned short*)(Pw + (4 * fq + i) * 160 + (nt * 16 + fr) * 2) = f2bf(acc[nt][i]);
        LDS_WAIT();
#pragma unroll
        for (int k = 0; k < 2; ++k) {
            const int c = lane + 64 * k, row = c >> 3, cc = c & 7;
            const u32x4 ov = *(const LAS u32x4*)(Pw + row * 160 + cc * 16);
            const size_t ro = (size_t)(tok0 + mt * 16 + row) * 6144 + hq * 64 + cc * 8;
            *(u32x4*)(Z + ro + 2048) = gate8(ov, gvs[k]);
        }
        LDS_WAIT();
    }
}

__device__ __forceinline__ void l2_flush_part(const float* base, size_t wg_bytes, int iters, int bid, int tid) {
    const u32x4* src = (const u32x4*)((const unsigned char*)base + (size_t)bid * wg_bytes) + tid;
    unsigned a = 0;
    {
        u32x4 v[8];
#pragma unroll
        for (int i = 0; i < 8; ++i) v[i] = src[i * 512];
#pragma unroll
        for (int i = 0; i < 8; ++i) a ^= v[i].x ^ v[i].y ^ v[i].z ^ v[i].w;
    }
#pragma unroll 1
    for (int i0 = 8; i0 < iters; i0 += 8) {
        asm volatile("s_waitcnt vmcnt(0)" ::: "memory");
        u32x4 v[8];
#pragma unroll
        for (int i = 0; i < 8; ++i) v[i] = src[(i0 + i) * 512];
#pragma unroll
        for (int i = 0; i < 8; ++i) a ^= (unsigned)__hip_atomic_load((const unsigned long long*)(src + (i0 - 8 + i) * 512), __ATOMIC_RELAXED, __HIP_MEMORY_SCOPE_AGENT);
#pragma unroll
        for (int i = 0; i < 8; ++i) a ^= v[i].x ^ v[i].y ^ v[i].z ^ v[i].w;
    }
    asm volatile("s_waitcnt vmcnt(0)" ::: "memory");
#pragma unroll
    for (int i = 0; i < 8; ++i) a ^= (unsigned)__hip_atomic_load((const unsigned long long*)(src + (iters - 8 + i) * 512), __ATOMIC_RELAXED, __HIP_MEMORY_SCOPE_AGENT);
    asm volatile("" :: "v"(a));
}
__device__ __noinline__ void l2_flush_x(const float* x, int bid, int tid) { l2_flush_part(x, 262144, 32, bid, tid); }
__device__ __forceinline__ void l2_flush(const Params& p, int bid, int tid) { l2_flush_x(p.x, bid, tid); return;
    l2_flush_part(p.x, 262144, 32, bid, tid);
}

#define XB_TMO      128
#define XB_XCNT(j)  (256  + 64 * (j))
#define XB_XSUB(j)  (1280 + 64 * (j))
#define XB_XGEN(j)  (2304 + 64 * (j))
#define XB_TOP      3328
#define XB_TOPGEN   3392
#define XCD_BAR_WORDS 3456
#define XB_SPIN_CAP (1u << 18)
__device__ __forceinline__ unsigned xb_ld(unsigned* p)              { return __hip_atomic_load(p, __ATOMIC_RELAXED, __HIP_MEMORY_SCOPE_AGENT); }
__device__ __forceinline__ unsigned xb_add(unsigned* p, unsigned v) { return __hip_atomic_fetch_add(p, v, __ATOMIC_RELAXED, __HIP_MEMORY_SCOPE_AGENT); }
__device__ __forceinline__ unsigned xb_xcc_id() { return (unsigned)__builtin_amdgcn_s_getreg((3 << 11) | 20) & 0xFu; }
#define XB_SPIN(cond, bar) do { unsigned _sp = 0; while (cond) { __builtin_amdgcn_s_sleep(1); \
    if ((++_sp & 255u) == 0u) { if (xb_ld(&(bar)[XB_TMO])) break; if (_sp > XB_SPIN_CAP) { atomicAdd(&(bar)[XB_TMO], 1u); break; } } } } while (0)
struct XcdBarrier { unsigned* bar; unsigned x; volatile LAS unsigned* st; };
__device__ __forceinline__ void xcd_barrier_complete(unsigned* bar, unsigned x, unsigned& nloc, unsigned& nx) {
    const unsigned G = gridDim.x * gridDim.y * gridDim.z;
    unsigned sum, cnt, mine, sp = 0u;
    for (;;) {
        sum = 0u; cnt = 0u; mine = 0u;
#pragma unroll
        for (unsigned j = 0; j < 16; ++j) { const unsigned c = xb_ld(&bar[XB_XCNT(j)]); sum += c; cnt += (c > 0u) ? 1u : 0u; mine = (j == x) ? c : mine; }
        if (sum == G) break;
        __builtin_amdgcn_s_sleep(1);
        if ((++sp & 255u) == 0u) { if (xb_ld(&bar[XB_TMO])) break; if (sp > XB_SPIN_CAP) { atomicAdd(&bar[XB_TMO], 1u); break; } }
    }
    nloc = mine > 0u ? mine : 1u; nx = cnt > 0u ? cnt : 1u;
}
__device__ __forceinline__ void xcd_barrier(const XcdBarrier& b) {
    asm volatile("s_waitcnt vmcnt(0)" ::: "memory");
    __syncthreads();
    if (threadIdx.x == 0) {
        unsigned* bar = b.bar;
        __builtin_amdgcn_s_waitcnt(0);
        unsigned nloc = b.st[0], nx = b.st[1];
        if (nloc == 0u) { xcd_barrier_complete(bar, b.x, nloc, nx); b.st[0] = nloc; b.st[1] = nx; }
        const unsigned old = xb_add(&bar[XB_XSUB(b.x)], 1u);
        const unsigned gen = old / nloc;
        if (old + 1u == (gen + 1u) * nloc) {
            __builtin_amdgcn_fence(__ATOMIC_RELEASE, "agent");
            asm volatile("s_waitcnt vmcnt(0)" ::: "memory");
            const unsigned og = xb_add(&bar[XB_TOP], 1u);
            const unsigned tg = og / nx;
            if (og + 1u == (tg + 1u) * nx) xb_add(&bar[XB_TOPGEN], 1u);
            else XB_SPIN(xb_ld(&bar[XB_TOPGEN]) == tg, bar);
            __builtin_amdgcn_fence(__ATOMIC_ACQUIRE, "agent");
            xb_add(&bar[XB_XGEN(b.x)], 1u);
            asm volatile("s_waitcnt vmcnt(0)" ::: "memory");
        } else {
            XB_SPIN(xb_ld(&bar[XB_XGEN(b.x)]) == gen, bar);
            __builtin_amdgcn_fence(__ATOMIC_ACQUIRE, "agent");
            asm volatile("s_waitcnt vmcnt(0)" ::: "memory");
        }
    }
    __syncthreads();
}
__global__ void __launch_bounds__(NTHREADS, 2) yoco_fwd(Params p) {
    extern __shared__ __attribute__((aligned(16))) unsigned char lds_raw[];
    LAS unsigned char* lds = (LAS unsigned char*)lds_raw;
    const int tid = threadIdx.x, lane = tid & 63, wave = __builtin_amdgcn_readfirstlane(tid >> 6);
    const int G = gridDim.x, bid = blockIdx.x;
    const int lo = p.ph_lo, hi = p.ph_hi;
    int ph = 0;
    int xrank;
    XcdBarrier xbar;
    {
        LAS unsigned* slot = (LAS unsigned*)(lds + 147456);
        xbar.bar = (unsigned*)(p.ws + 16384); xbar.x = xb_xcc_id(); xbar.st = (volatile LAS unsigned*)(lds + 147456 + 16);
        if (tid == 0) { slot[0] = xb_add(&xbar.bar[XB_XCNT(xbar.x)], 1u); slot[4] = 0u; slot[5] = 0u; }
        __syncthreads();
        xrank = __builtin_amdgcn_readfirstlane((int)(slot[0] & 31u));
        __syncthreads();
    }
#define IN_PH() (ph >= lo && ph < hi)
#if MK_SINGLE
#define SEAM(FL) do { if (ph >= lo && ph + 1 < hi) { asm volatile("s_waitcnt vmcnt(0)" ::: "memory"); if (FL) { l2_flush(p, xrank, tid); asm volatile("s_waitcnt vmcnt(0)" ::: "memory"); } if (lo < 0) cg::this_grid().sync();     xcd_barrier(xbar); } ++ph; } while (0)
#else
#define SEAM(FL) do { ++ph; } while (0)
#endif
#define LOCAL_PTRS() int wz_ = 0; asm volatile("" : "+s"(wz_)); unsigned char* ws = p.ws + wz_; \
    bf16_t* YN = (bf16_t*)(ws + WS_YN); bf16_t* Z = (bf16_t*)(ws + WS_Z); bf16_t* WNAT = (bf16_t*)(ws + WS_WNAT); bf16_t* WSWP = (bf16_t*)(ws + WS_WSWP); bf16_t* WOUT = (bf16_t*)(ws + WS_WOUT); \
    (void)YN; (void)Z; (void)WNAT; (void)WSWP; (void)WOUT

    if (EN(0) && IN_PH()) phase_p0(p, lds, tid, wave, lane);
    SEAM(true);

    for (int l = 0; l < 4; ++l) {
        const bool isA = l < 2;
        if (IN_PH()) {
            LOCAL_PTRS();
            if (isA) {
                if (EN(1)) { pg8::Gemm g{YN, WNAT, T, 8192, D, D, D}; pg8::StaticOrder S; S.init(T, 8192, G, bid);
                  EpiNat E{Z, 8192, 16, (const f32x4*)(ws + WS_TABN), 0, -1, nullptr, nullptr};
                  pg8::gemm_phase<EpiNat, true>(lds, g, S, E); }
                if (EN(2)) { pg8::Gemm g{WSWP + (size_t)2048 * D, YN, 2048, T, D, D, D}; pg8::StaticOrder S; S.init(2048, T, G, bid);
                  EpiSwp E{(bf16_t*)(ws + WS_KVT) + (size_t)2048 * T, T, 0, nullptr, nullptr};
                  pg8::gemm_phase<EpiSwp, true>(lds, g, S, E); }
                if (EN(3) && l == 0) {
                    { pg8::Gemm g{(const bf16_t*)(ws + WS_MEMN), (const bf16_t*)(ws + WS_WMK), 1024, 4096, D, D, D}; pg8::StaticOrder S; S.init(1024, 4096, G, bid);
                      EpiNat E{(bf16_t*)(ws + WS_MK), 4096, 0, nullptr, 0, -1, nullptr, nullptr};
                      pg8::gemm_phase<EpiNat, true>(lds, g, S, E); }
                    { pg8::Gemm g{(const bf16_t*)(ws + WS_WMV), (const bf16_t*)(ws + WS_MEMN), 4096, 1024, D, D, D}; pg8::StaticOrder S; S.init(4096, 1024, G, (bid + 192) & 255);
                      EpiSwp E{(bf16_t*)(ws + WS_MVT), 1024, 0, nullptr, nullptr};
                      pg8::gemm_phase<EpiSwp, true>(lds, g, S, E); }
                }
            } else if (EN(4)) {
                const int N = (l == 2) ? 6400 : 6144;
                { pg8::Gemm g{YN, WNAT, T, N, D, D, D}; pg8::StaticOrder S; S.init(T, N, G, bid);
                  EpiNat E{Z, 6144, 0, nullptr, 8, (l == 2) ? 24 : -1, (bf16_t*)(ws + WS_KS), (const f32x4*)(ws + WS_SWAT)};
                  pg8::gemm_phase<EpiNat, true>(lds, g, S, E); }
                if (l == 2) {
                    pg8::Gemm g{WSWP, YN, 256, T, D, D, D}; pg8::StaticOrder S; S.init(256, T, G, (bid + 192) & 255);
                    EpiSwp E{(bf16_t*)(ws + WS_VST), T, 0, nullptr, nullptr};
                    pg8::gemm_phase<EpiSwp, true>(lds, g, S, E);
                }
            }
        }
        SEAM(true);
        if (isA) {
            if (IN_PH()) {
                LOCAL_PTRS();
                if (EN(5)) { __syncthreads(); for (int u = bid; u < 256; u += G) scan_unit(Z, (const bf16_t*)(ws + WS_KVT), (bf16_t*)(ws + WS_RT), lds, u, wave, lane); }
                if (EN(6)) for (int u = bid; u < 512; u += G) memattn_unit(p, l, u, 8192, 6144, lds, tid, wave, lane);
            }
            SEAM(true);
            if (EN(7) && IN_PH()) { for (int u = bid; u < 1024; u += G) retc_unit(p, u, lds, tid, wave, lane); }
            SEAM(false);
        } else {
            if (IN_PH()) {
                if (EN(8)) for (int u = bid; u < 512; u += G) swa_unit(p, l - 2, u, lds, tid, wave, lane);
                if (EN(6)) for (int u = bid; u < 512; u += G) memattn_unit(p, l, u, 6144, 4096, lds, tid, wave, lane);
            }
            SEAM(true);
        }
        if (EN(9) && IN_PH()) {
            LOCAL_PTRS();
            __syncthreads();
            pg8::StaticOrder S; S.init(T, D, G, bid);
            EpiNat E{(bf16_t*)(ws + WS_OUTF), D, 0, nullptr, 0, -1, nullptr, nullptr};
            if (isA) { pg8::Gemm g{Z + 4096, WOUT, T, D, 3072, 8192, 3072}; pg8::gemm_phase<EpiNat, true>(lds, g, S, E); }
            else     { pg8::Gemm g{Z + 2048, WOUT, T, D, 3072, 6144, 3072}; pg8::gemm_phase<EpiNat, true>(lds, g, S, E); }
        }
        SEAM(isA);
        if (EN(10) && IN_PH()) { __syncthreads(); phase_norm(p, l, lds, wave, lane); }
        SEAM(false);
    }
}
constexpr int N_PHASES = 1 + 2 * 5 + 2 * 4;
#ifndef PROBE_PH
#define PROBE_PH -1
#endif
#ifndef PROBE_OFF
#define PROBE_OFF WS_Z
#endif
__global__ void probe_copy(const bf16_t* src, float* out, size_t n) {
    for (size_t i = (size_t)blockIdx.x * blockDim.x + threadIdx.x; i < n; i += (size_t)gridDim.x * blockDim.x) out[i] = bf2f(src[i]);
}

extern "C" void kernel_launch(void* const* d_in, const int* in_sizes, int n_in, void* d_out, int out_size, void* d_ws, size_t ws_size, hipStream_t stream) {
    static int grid = 0;
    if (grid == 0) {
        if (n_in != 13 || ws_size < WS_END) { fprintf(stderr, "kernel_launch: unexpected n_in %d or ws_size %zu (< %zu)\n", n_in, ws_size, (size_t)WS_END); grid = -1; return; }
        if (hipFuncSetAttribute((const void*)yoco_fwd, hipFuncAttributeMaxDynamicSharedMemorySize, LDS_BYTES) != hipSuccess) { fprintf(stderr, "kernel_launch: hipFuncSetAttribute failed\n"); grid = -1; return; }
        int dev = 0, cus = 0, per_cu = 0;
        (void)hipGetDevice(&dev); (void)hipDeviceGetAttribute(&cus, hipDeviceAttributeMultiprocessorCount, dev);
        (void)hipOccupancyMaxActiveBlocksPerMultiprocessor(&per_cu, (const void*)yoco_fwd, NTHREADS, LDS_BYTES);
        if (per_cu < 1) { fprintf(stderr, "kernel_launch: occupancy query says %d blocks per CU\n", per_cu); per_cu = 1; }
        (void)hipGetLastError();
        grid = cus;
    }
    if (grid < 0) return;
    Params p{};
    p.x = (const float*)d_in[0]; p.mem = (const float*)d_in[1]; p.pos = (const int*)d_in[2]; p.pre_g = (const float*)d_in[3]; p.post_g = (const float*)d_in[4];
    p.mem_g = (const float*)d_in[5]; p.kv_g = (const float*)d_in[6]; p.w_in_a = (const float*)d_in[7]; p.w_in_b = (const float*)d_in[8]; p.w_kv_b = (const float*)d_in[9];
    p.sinks = (const float*)d_in[10]; p.w_mem_kv = (const float*)d_in[11]; p.w_out = (const float*)d_in[12];
    p.out = (float*)d_out; p.ws = (unsigned char*)d_ws;
    for (int j = 0; j < 128; ++j) p.inv_ret[j] = (float)pow(10000.0, -(double)(2 * j) / 256.0);
    for (int j = 0; j < 8; ++j) p.inv_swa[j] = (float)pow(500000.0, -(double)(2 * j) / 16.0);
#if MK_SINGLE
    p.ph_lo = 0; p.ph_hi = N_PHASES;
    (void)hipMemsetAsync(d_ws, 0, 32768, stream);
    void* args[] = {&p};
    hipError_t e = hipLaunchCooperativeKernel((const void*)yoco_fwd, dim3(grid), dim3(NTHREADS), args, LDS_BYTES, stream);
    if (e != hipSuccess) fprintf(stderr, "kernel_launch: cooperative launch failed: %s (grid %d)\n", hipGetErrorString(e), grid);
#else
    for (int ph = 0; ph < N_PHASES; ++ph) {
        p.ph_lo = ph; p.ph_hi = ph + 1;
        hipLaunchKernelGGL(yoco_fwd, dim3(grid), dim3(NTHREADS), LDS_BYTES, stream, p);
#ifdef SNAP_PH
        if (ph == SNAP_PH) (void)hipMemcpyAsync((unsigned char*)d_ws + 626 * MiB, (unsigned char*)d_ws + SNAP_OFF, 14 * MiB, hipMemcpyDeviceToDevice, stream);
#endif
#ifdef STOP_PH
        if (ph == STOP_PH) break;
#endif
#ifdef SNAP_PH
        if (ph == N_PHASES - 1) { (void)hipMemsetAsync(d_out, 0, (size_t)T * D * 4, stream);
            hipLaunchKernelGGL(probe_copy, dim3(2048), dim3(256), 0, stream, (const bf16_t*)((unsigned char*)d_ws + 626 * MiB), (float*)d_out, (size_t)7 * 1024 * 1024); }
#endif
        if (ph == PROBE_PH) { hipLaunchKernelGGL(probe_copy, dim3(2048), dim3(256), 0, stream, (const bf16_t*)((unsigned char*)d_ws + PROBE_OFF), (float*)d_out, (size_t)T * D); break; }
    }
#endif
}
```

```cpp
#include <hip/hip_runtime.h>
#include <hip/hip_cooperative_groups.h>
#include <cstdio>
#include <cstdint>
#include <cmath>
namespace cg = cooperative_groups;

#ifndef MK_SINGLE
#define MK_SINGLE 1
#endif

#ifndef EN_MASK
#define EN_MASK 0xFFFF
#endif
#define EN(b) ((EN_MASK >> (b)) & 1)
#define LAS __attribute__((address_space(3)))
typedef unsigned short bf16_t;
typedef short bf16x8 __attribute__((ext_vector_type(8)));
typedef float f32x4 __attribute__((ext_vector_type(4)));
typedef float f32x2 __attribute__((ext_vector_type(2)));
typedef unsigned u32x4 __attribute__((ext_vector_type(4)));
typedef unsigned u32x2 __attribute__((ext_vector_type(2)));

constexpr int T = 16384, D = 2048, SEQ = 4096;
constexpr float EPS = 1e-6f;
constexpr int NTHREADS = 512, NWAVES = 8;

constexpr size_t MiB = 1u << 20;
constexpr size_t WS_TABN = 1 * MiB;
constexpr size_t WS_COST = 17 * MiB;
constexpr size_t WS_SINT = 25 * MiB;
constexpr size_t WS_KS   = 1 * MiB;
constexpr size_t WS_VST  = 9 * MiB;
constexpr size_t WS_SWAT = 33 * MiB;
constexpr size_t WS_MEMN = 34 * MiB;
constexpr size_t WS_MK   = 38 * MiB;
constexpr size_t WS_MVT  = 46 * MiB;
constexpr size_t WS_WNAT = 54 * MiB;
constexpr size_t WS_WSWP = 86 * MiB;
constexpr size_t WS_WOUT = 102 * MiB;
constexpr size_t WS_Z    = 114 * MiB;
constexpr size_t WS_KVT  = 370 * MiB;
constexpr size_t WS_OUTF = 370 * MiB;
constexpr size_t WS_RT   = 498 * MiB;
constexpr size_t WS_YN   = 498 * MiB;
constexpr size_t WS_WMK  = 562 * MiB;
constexpr size_t WS_WMV  = 578 * MiB;
constexpr size_t WS_END  = 626 * MiB;

constexpr int LDS_BYTES = 147456 + 64;
constexpr int REG_B = 73728;

struct Params {
    const float* x; const float* mem; const int* pos; const float* pre_g; const float* post_g; const float* mem_g; const float* kv_g;
    const float* w_in_a; const float* w_in_b; const float* w_kv_b; const float* sinks; const float* w_mem_kv; const float* w_out;
    float* out; unsigned char* ws; int ph_lo, ph_hi;
    float inv_ret[128]; float inv_swa[8];
};

namespace pg8 {
constexpr int BM = 256, BK = 64, HALF = 128, HTB = HALF * BK * 2, STAGE_BYTES = 8 * HTB, NXCD = 8, WGM = 8;
__host__ __device__ __forceinline__ int lds_byte(int r, int c) { const int st = (r >> 4) * 2 + (c >> 5), rr = r & 15, cc = c & 31, ob = rr * 64 + cc * 2; return st * 1024 + (ob ^ (((ob >> 9) & 1) << 5)); }
__host__ __device__ __forceinline__ void stage_rc(int b, int& R, int& C) { const int st = b / 1024, sb = b % 1024, swz = sb ^ (((sb >> 9) & 1) << 5); R = (st >> 1) * 16 + swz / 64; C = (st & 1) * 32 + (swz % 64) / 2; }
__host__ __device__ __forceinline__ int perm32(int rho) { const int n = rho >> 4, i = rho & 15; return 8 * (i >> 2) + 4 * n + (i & 3); }

struct Unit { int pm, pn; };
struct Gemm { const bf16_t* A; const bf16_t* Bt; int M, N, K, lda, ldb; };

struct StaticOrder {
    int nM, nN, nwg, G, c;
    __host__ __device__ void init(int M, int N, int G_, int c_) { nM = M / BM; nN = N / BM; nwg = nM * nN; G = G_; c = c_; }
    __host__ __device__ bool next(int i, Unit& u) const {
        const long L = (long)i * G + c; if (L >= nwg) return false;
        int wgid = (int)L; { const int q = nwg / NXCD, r = nwg % NXCD, xcd = wgid % NXCD, off = wgid / NXCD; wgid = (xcd < r ? xcd * (q + 1) : r * (q + 1) + (xcd - r) * q) + off; }
        const int nig = WGM * nN, gid = wgid / nig, fm = gid * WGM, gsz = (nM - fm) < WGM ? (nM - fm) : WGM;
        u.pm = fm + ((wgid % nig) % gsz); u.pn = (wgid % nig) / gsz; return true;
    }
};

typedef _Float16 f16x2_t __attribute__((ext_vector_type(2)));
typedef _Float16 f16x8_t __attribute__((ext_vector_type(8)));
__device__ __forceinline__ unsigned cvt_pk_bf16(float lo, float hi) { const f16x2_t v = {(_Float16)lo, (_Float16)hi}; return __builtin_bit_cast(unsigned, v); }

template <class Epi, bool ALIGN_EPI>
__device__ __forceinline__ void gemm_phase(LAS unsigned char* lds, const Gemm g_in, const StaticOrder& S, const Epi& E) {
    Gemm g = g_in;
    { const bf16_t* a_ = g.A; const bf16_t* b_ = g.Bt; asm volatile("" : "+s"(a_), "+s"(b_)); g.A = a_; g.Bt = b_; }
    int tid = threadIdx.x; asm volatile("" : "+v"(tid));
    const int wid = __builtin_amdgcn_readfirstlane(tid >> 6), lane = tid & 63, wr = wid >> 2, wc = wid & 3, fr = lane & 15, fq = lane >> 4;
    const int K = g.K, nt = K / BK;
    unsigned voffA[2], voffB[2];
#pragma unroll
    for (int i = 0; i < 2; ++i) { int R, C; stage_rc(tid * 16 + i * 8192, R, C); const int Rb = Epi::PERM ? ((R & ~31) + perm32(R & 31)) : R;
        voffA[i] = (unsigned)(R * g.lda + C) * 2u; voffB[i] = (unsigned)(Rb * g.ldb + C) * 2u; }
    const size_t kstep = (size_t)(BK * 2);
    const size_t hstepA = (size_t)HALF * g.lda * 2, hstepB = (size_t)HALF * g.ldb * 2;
    const size_t tstepA = 2 * hstepA, tstepB = 2 * hstepB;
    const unsigned ldsw = (unsigned)wid * 1024u;
    const int aoff = lds_byte(wr * 64 + fr, fq * 8), boff = lds_byte(wc * 32 + fr, fq * 8);
#define PG8_SA(b, h) (((b) * 2 + (h)) * HTB)
#define PG8_SB(b, h) ((4 + (b) * 2 + (h)) * HTB)
#define PG8_STAGE(bufoff, gbase, voff) do { _Pragma("unroll") for (int _i = 0; _i < 2; ++_i) \
        __builtin_amdgcn_global_load_lds((const unsigned*)((const char*)(gbase) + (voff)[_i]), (LAS unsigned*)(lds + (bufoff) + ldsw + _i * 8192), 16, 0, 0); } while (0)
#define PG8_LDA(dst, b, h) do { _Pragma("unroll") for (int m = 0; m < 4; ++m) _Pragma("unroll") for (int k = 0; k < 2; ++k) dst[m][k] = *(const LAS bf16x8*)(lds + PG8_SA(b, h) + aoff + m * 2048 + k * 1024); } while (0)
#define PG8_LDB(dst, b, h) do { _Pragma("unroll") for (int n = 0; n < 2; ++n) _Pragma("unroll") for (int k = 0; k < 2; ++k) dst[n][k] = *(const LAS bf16x8*)(lds + PG8_SB(b, h) + boff + n * 2048 + k * 1024); } while (0)
#define PG8_MMA(ai, bj, At, Bt) do { __builtin_amdgcn_s_setprio(1); _Pragma("unroll") for (int m = 0; m < 4; ++m) _Pragma("unroll") for (int n = 0; n < 2; ++n) _Pragma("unroll") for (int k = 0; k < 2; ++k) \
        acc[ai][bj][m][n] = __builtin_amdgcn_mfma_f32_16x16x32_f16(__builtin_bit_cast(f16x8_t, Bt[n][k]), __builtin_bit_cast(f16x8_t, At[m][k]), acc[ai][bj][m][n], 0, 0, 0); __builtin_amdgcn_s_setprio(0); } while (0)
#define PG8_WAIT_V(n) asm volatile("s_waitcnt vmcnt(" #n ")" ::: "memory")
#define PG8_WAIT_L(n) asm volatile("s_waitcnt lgkmcnt(" #n ")" ::: "memory")
#define PG8_BAR __builtin_amdgcn_s_barrier()
#define PG8_SCHED __builtin_amdgcn_sched_barrier(0)
    Unit cur, nxt; int ui = 0;
    if (!S.next(0, cur)) return;
    f32x4 acc[2][2][4][2];
#pragma unroll
    for (int a = 0; a < 2; ++a)
#pragma unroll
        for (int b = 0; b < 2; ++b)
#pragma unroll
            for (int m = 0; m < 4; ++m)
#pragma unroll
                for (int n = 0; n < 2; ++n) acc[a][b][m][n] = (f32x4){0.f, 0.f, 0.f, 0.f};
    bf16x8 At[4][2], B0[2][2], B1[2][2];
    const char* cA = (const char*)g.A + (size_t)cur.pm * tstepA; const char* cB = (const char*)g.Bt + (size_t)cur.pn * tstepB;
    PG8_STAGE(PG8_SB(0, 0), cB, voffB); PG8_STAGE(PG8_SB(0, 1), cB + hstepB, voffB); PG8_STAGE(PG8_SA(0, 0), cA, voffA); PG8_STAGE(PG8_SA(0, 1), cA + hstepA, voffA);
    if (wr == 1) PG8_BAR;
    PG8_WAIT_V(2); PG8_BAR;
    PG8_STAGE(PG8_SB(1, 0), cB + kstep, voffB); PG8_STAGE(PG8_SA(1, 0), cA + kstep, voffA); PG8_STAGE(PG8_SB(1, 1), cB + hstepB + kstep, voffB);
    PG8_WAIT_V(6); PG8_BAR;
    for (;;) {
        const bool has_next = S.next(ui + 1, nxt);
        const char* nA = has_next ? (const char*)g.A + (size_t)nxt.pm * tstepA : cA; const char* nB = has_next ? (const char*)g.Bt + (size_t)nxt.pn * tstepB : cB;
        for (int t = 0; t < nt; t += 2) {
            const bool last = (t == nt - 2);
            const char* a1 = cA + (size_t)(t + 1) * kstep;
            const char* a2 = last ? nA : cA + (size_t)(t + 2) * kstep; const char* b2 = last ? nB : cB + (size_t)(t + 2) * kstep;
            const char* a3 = a2 + kstep; const char* b3 = b2 + kstep;
            PG8_LDB(B0, 0, 0); PG8_LDB(B1, 0, 1); PG8_SCHED; PG8_LDA(At, 0, 0); PG8_STAGE(PG8_SA(1, 1), a1 + hstepA, voffA);
            PG8_WAIT_V(8); PG8_WAIT_L(0); PG8_BAR; PG8_MMA(0, 0, At, B0); PG8_MMA(0, 1, At, B1); PG8_BAR; PG8_SCHED;
            PG8_LDA(At, 0, 1); PG8_STAGE(PG8_SB(0, 0), b2, voffB); PG8_STAGE(PG8_SB(0, 1), b2 + hstepB, voffB); PG8_STAGE(PG8_SA(0, 0), a2, voffA);
            PG8_WAIT_V(8); PG8_WAIT_L(0); PG8_BAR; PG8_MMA(1, 0, At, B0); PG8_MMA(1, 1, At, B1); PG8_BAR; PG8_SCHED;
            PG8_LDB(B0, 1, 0); PG8_LDB(B1, 1, 1); PG8_SCHED; PG8_LDA(At, 1, 0); PG8_STAGE(PG8_SA(0, 1), a2 + hstepA, voffA);
            PG8_WAIT_V(8); PG8_WAIT_L(0); PG8_BAR; PG8_MMA(0, 0, At, B0); PG8_MMA(0, 1, At, B1); PG8_BAR; PG8_SCHED;
            PG8_LDA(At, 1, 1); PG8_STAGE(PG8_SB(1, 0), b3, voffB); PG8_STAGE(PG8_SB(1, 1), b3 + hstepB, voffB); PG8_STAGE(PG8_SA(1, 0), a3, voffA);
            PG8_WAIT_V(8); PG8_WAIT_L(0); PG8_BAR; PG8_MMA(1, 0, At, B0); PG8_MMA(1, 1, At, B1); PG8_BAR; PG8_SCHED;
        }
        if constexpr (ALIGN_EPI) { if (wr == 0) PG8_BAR; }
        { int fr_ = fr, fq_ = fq; asm volatile("" : "+v"(fr_), "+v"(fq_)); E(acc, cur, wr, wc, fr_, fq_); }
        if (!has_next) break;
#pragma unroll
        for (int a = 0; a < 2; ++a)
#pragma unroll
            for (int b = 0; b < 2; ++b)
#pragma unroll
                for (int m = 0; m < 4; ++m)
#pragma unroll
                    for (int n = 0; n < 2; ++n) acc[a][b][m][n] = (f32x4){0.f, 0.f, 0.f, 0.f};
        cur = nxt; cA = nA; cB = nB; ++ui;
        if constexpr (ALIGN_EPI) { if (wr == 1) PG8_BAR; }
    }
    PG8_WAIT_V(0);
    if constexpr (!ALIGN_EPI) { if (wr == 0) PG8_BAR; }
    PG8_BAR;
#undef PG8_SA
#undef PG8_SB
#undef PG8_STAGE
#undef PG8_LDA
#undef PG8_LDB
#undef PG8_MMA
#undef PG8_WAIT_V
#undef PG8_WAIT_L
#undef PG8_BAR
#undef PG8_SCHED
}
}
using pg8::cvt_pk_bf16;

__device__ __forceinline__ float shx(float v, int mask, int lane) { return __int_as_float(__builtin_amdgcn_ds_bpermute((lane ^ mask) << 2, __float_as_int(v))); }
__device__ __forceinline__ u32x4 pack8(const f32x4 a, const f32x4 b) { u32x4 w; w.x = cvt_pk_bf16(a[0], a[1]); w.y = cvt_pk_bf16(a[2], a[3]); w.z = cvt_pk_bf16(b[0], b[1]); w.w = cvt_pk_bf16(b[2], b[3]); return w; }

struct EpiNat {
    static constexpr bool PERM = true;
    bf16_t* O; int ldc; int rope_tiles; const f32x4* tabN; int swa_tiles; int kred_pn; bf16_t* KS; const f32x4* swaTab;
    __device__ __forceinline__ void operator()(const f32x4 (&acc)[2][2][4][2], const pg8::Unit& u, int wr, int wc, int fr, int fq) const {
        const int row0 = u.pm * 256 + wr * 64 + fr; const int pn = u.pn;
        if (rope_tiles && (pn < 8 || (pn >= 16 && pn < 24))) {
            const float sc = pn < 8 ? 0.0625f : 1.f;
#pragma unroll
            for (int ai = 0; ai < 2; ++ai)
#pragma unroll
                for (int m = 0; m < 4; ++m) {
                    const int r = row0 + ai * 128 + m * 16;
                    const f32x4* tp = tabN + ((size_t)r * 128 + wc * 32 + fq * 8) / 2;
                    const f32x4 t0 = tp[0], t1 = tp[1], t2 = tp[2], t3 = tp[3];
                    f32x4 o1[2], o2[2];
#pragma unroll
                    for (int n = 0; n < 2; ++n) {
                        const f32x4 ta = n ? t2 : t0, tb = n ? t3 : t1;
                        const f32x4 c = (f32x4){ta[0], ta[2], tb[0], tb[2]}, s = (f32x4){ta[1], ta[3], tb[1], tb[3]};
                        const f32x4 x1 = acc[ai][0][m][n], x2 = acc[ai][1][m][n];
                        o1[n] = (x1 * c - x2 * s) * sc; o2[n] = (x2 * c + x1 * s) * sc;
                    }
                    bf16_t* rowp = O + (size_t)r * ldc + pn * 256 + wc * 32 + 8 * fq;
                    *(u32x4*)(rowp) = pack8(o1[0], o1[1]); *(u32x4*)(rowp + 128) = pack8(o2[0], o2[1]);
                    asm volatile("" ::: "memory");
                }
        } else if ((swa_tiles && pn >= 8 && pn < 16) || pn == kred_pn) {
            bf16_t* base = O; int ld = ldc; int colt = pn * 256;
            if (pn == kred_pn) { base = KS; ld = 256; colt = 0; }
            const bool rot = (wc & 1) == 0;
#pragma unroll
            for (int ai = 0; ai < 2; ++ai)
#pragma unroll
                for (int m = 0; m < 4; ++m) {
                    const int r = row0 + ai * 128 + m * 16;
                    f32x4 v[2][2];
#pragma unroll
                    for (int bj = 0; bj < 2; ++bj)
#pragma unroll
                        for (int n = 0; n < 2; ++n) v[bj][n] = acc[ai][bj][m][n];
                    if (rot) {
                        const f32x4* tp = swaTab + (size_t)r * 4;
                        const f32x4 t0 = tp[0], t1 = tp[1], t2 = tp[2], t3 = tp[3];
#pragma unroll
                        for (int n = 0; n < 2; ++n) {
                            const f32x4 ta = n ? t2 : t0, tb = n ? t3 : t1;
                            const f32x4 c = (f32x4){ta[0], ta[2], tb[0], tb[2]}, s = (f32x4){ta[1], ta[3], tb[1], tb[3]};
#pragma unroll
                            for (int bj = 0; bj < 2; ++bj) {
                                f32x4 x = v[bj][n], px;
#pragma unroll
                                for (int i = 0; i < 4; ++i) px[i] = shx(x[i], 16, fq * 16 + fr);
                                const f32x4 lo = x * c - px * s, hi = x * c + px * s;
                                v[bj][n] = fq == 0 ? lo : (fq == 1 ? hi : x);
                            }
                        }
                    }
                    bf16_t* rowp = base + (size_t)r * ld + colt + wc * 32 + 8 * fq;
                    *(u32x4*)(rowp) = pack8(v[0][0], v[0][1]); *(u32x4*)(rowp + 128) = pack8(v[1][0], v[1][1]);
                    asm volatile("" ::: "memory");
                }
        } else {
#pragma unroll
            for (int ai = 0; ai < 2; ++ai)
#pragma unroll
                for (int m = 0; m < 4; ++m) {
                    bf16_t* rowp = O + (size_t)(row0 + ai * 128 + m * 16) * ldc + pn * 256 + wc * 32 + 8 * fq;
                    *(u32x4*)(rowp) = pack8(acc[ai][0][m][0], acc[ai][0][m][1]); *(u32x4*)(rowp + 128) = pack8(acc[ai][1][m][0], acc[ai][1][m][1]);
                }
        }
    }
};

struct EpiSwp {
    static constexpr bool PERM = true;
    bf16_t* O; int ldc; int rope_row_tiles; const float* cosT; const float* sinT;
    __device__ __forceinline__ void operator()(const f32x4 (&acc)[2][2][4][2], const pg8::Unit& u, int wr, int wc, int fr, int fq) const {
        const int row0 = u.pm * 256 + wr * 64 + fr, col0 = u.pn * 256 + wc * 32 + 8 * fq;
        if (u.pm < rope_row_tiles) {
            const float lg = logf(1.f - exp2f(-5.f - (float)u.pm));
            f32x4 zeta[2];
#pragma unroll
            for (int n = 0; n < 2; ++n)
#pragma unroll
                for (int i = 0; i < 4; ++i) zeta[n][i] = expf(lg * (float)(127 - (wc * 32 + fq * 8 + n * 4 + i))) * 0.0625f;
#pragma unroll
            for (int m = 0; m < 4; ++m) {
                const int j = wr * 64 + m * 16 + fr;
#pragma unroll
                for (int bj = 0; bj < 2; ++bj) {
                    f32x4 o1[2], o2[2];
#pragma unroll
                    for (int n = 0; n < 2; ++n) {
                        const size_t to = (size_t)j * T + col0 + bj * 128 + n * 4;
                        const f32x4 c = *(const f32x4*)(cosT + to), s = *(const f32x4*)(sinT + to);
                        const f32x4 x1 = acc[0][bj][m][n], x2 = acc[1][bj][m][n];
                        o1[n] = (x1 * c - x2 * s) * zeta[n]; o2[n] = (x2 * c + x1 * s) * zeta[n];
                    }
                    bf16_t* p1 = O + (size_t)(row0 + m * 16) * ldc + col0 + bj * 128;
                    *(u32x4*)(p1) = pack8(o1[0], o1[1]); *(u32x4*)(p1 + (size_t)128 * ldc) = pack8(o2[0], o2[1]);
                    asm volatile("" ::: "memory");
                }
            }
        } else {
#pragma unroll
            for (int ai = 0; ai < 2; ++ai)
#pragma unroll
                for (int m = 0; m < 4; ++m) {
                    bf16_t* rowp = O + (size_t)(row0 + ai * 128 + m * 16) * ldc + col0;
                    *(u32x4*)(rowp) = pack8(acc[ai][0][m][0], acc[ai][0][m][1]); *(u32x4*)(rowp + 128) = pack8(acc[ai][1][m][0], acc[ai][1][m][1]);
                }
        }
    }
};

struct EpiF32 {
    static constexpr bool PERM = false;
    float* C; int ldc;
    __device__ __forceinline__ void operator()(const f32x4 (&acc)[2][2][4][2], const pg8::Unit& u, int wr, int wc, int fr, int fq) const {
        const int row0 = u.pm * 256 + wr * 64 + fr, col0 = u.pn * 256 + wc * 32 + 4 * fq;
#pragma unroll
        for (int ai = 0; ai < 2; ++ai)
#pragma unroll
            for (int m = 0; m < 4; ++m) { float* rowp = C + (size_t)(row0 + ai * 128 + m * 16) * ldc + col0;
#pragma unroll
                for (int bj = 0; bj < 2; ++bj)
#pragma unroll
                    for (int n = 0; n < 2; ++n) *(f32x4*)(rowp + bj * 128 + n * 16) = acc[ai][bj][m][n]; }
    }
};

__device__ __forceinline__ float wave_sum(float v, int lane) {
#pragma unroll
    for (int o = 1; o < 64; o <<= 1) v += shx(v, o, lane);
    return v;
}
__device__ __forceinline__ float bf2f(unsigned short b) { return (float)__builtin_bit_cast(_Float16, b); }
__device__ __forceinline__ float bflo(unsigned w) { return (float)__builtin_bit_cast(_Float16, (unsigned short)(w & 0xffffu)); }
__device__ __forceinline__ float bfhi(unsigned w) { return (float)__builtin_bit_cast(_Float16, (unsigned short)(w >> 16)); }
__device__ __forceinline__ unsigned short f2bf(float f) { return (unsigned short)(cvt_pk_bf16(f, 0.f) & 0xffffu); }
__device__ __forceinline__ f32x4 mfma16(bf16x8 a, bf16x8 b, f32x4 c) { return __builtin_amdgcn_mfma_f32_16x16x32_f16(__builtin_bit_cast(pg8::f16x8_t, a), __builtin_bit_cast(pg8::f16x8_t, b), c, 0, 0, 0); }
__device__ __forceinline__ bf16x8 ldg8(const bf16_t* p) { return *(const bf16x8*)p; }
__device__ __forceinline__ bf16x8 lds8(const LAS unsigned char* p) { return *(const LAS bf16x8*)p; }
__device__ __forceinline__ float silu(float g) { return g / (1.f + __expf(-g)); }
#define LDS_WAIT() asm volatile("s_waitcnt lgkmcnt(0)" ::: "memory")

template <int ROWS, int ROWB, int LP>
__device__ __forceinline__ void stage_tile(LAS unsigned char* dst, const unsigned char* src, size_t gpitch, int tid) {
    constexpr int CPR = ROWB / 16, TOTAL = ROWS * CPR, ITER = TOTAL / NTHREADS;
    static_assert(TOTAL % NTHREADS == 0, "stage_tile");
    constexpr int BATCH = ITER < 8 ? ITER : 8;
    static_assert(ITER % BATCH == 0, "stage_tile batch");
#pragma unroll
    for (int k0 = 0; k0 < ITER; k0 += BATCH) {
        u32x4 v[BATCH];
#pragma unroll
        for (int k = 0; k < BATCH; ++k) { const int c = tid + (k0 + k) * NTHREADS, r = c / CPR, cc = c % CPR; v[k] = *(const u32x4*)(src + (size_t)r * gpitch + cc * 16); }
#pragma unroll
        for (int k = 0; k < BATCH; ++k) { const int c = tid + (k0 + k) * NTHREADS, r = c / CPR, cc = c % CPR; *(LAS u32x4*)(dst + r * LP + cc * 16) = v[k]; }
        asm volatile("" ::: "memory");
    }
}

__device__ __forceinline__ u32x4 gate8(u32x4 o, u32x4 g) {
    u32x4 r;
#pragma unroll
    for (int k = 0; k < 4; ++k) r[k] = cvt_pk_bf16(bflo(o[k]) * silu(bflo(g[k])), bfhi(o[k]) * silu(bfhi(g[k])));
    return r;
}

__device__ __forceinline__ void sincos_f(float ang, float& c, float& s) {
    const double a = (double)ang, k = rint(a * 0.63661977236758134308);
    double r = fma(-k, 1.57079632679489661923, a); r = fma(-k, 6.123233995736766e-17, r);
    const double r2 = r * r;
    const double sn = r * (1.0 + r2 * (-1.0 / 6 + r2 * (1.0 / 120 + r2 * (-1.0 / 5040 + r2 * (1.0 / 362880 + r2 * (-1.0 / 39916800))))));
    const double cs = 1.0 + r2 * (-0.5 + r2 * (1.0 / 24 + r2 * (-1.0 / 720 + r2 * (1.0 / 40320 + r2 * (-1.0 / 3628800 + r2 * (1.0 / 479001600))))));
    const int q = ((int)k) & 3;
    const float fs = (float)sn, fc = (float)cs;
    c = (q == 0) ? fc : (q == 1) ? -fs : (q == 2) ? -fc : fs;
    s = (q == 0) ? fs : (q == 1) ? fc : (q == 2) ? -fs : -fc;
}

__device__ __forceinline__ void convert_block(const float* W, int ldw, int col0, int ncols, int K, const float* gain, bf16_t* WT, LAS float* scr, int gw, int NGW, int lane) {
    const int nblk = ncols / 32, items = (K / 64) * nblk;
    for (int it = gw; it < items; it += NGW) {
        const int kb = it / nblk, nb = it % nblk, k0 = 64 * kb, n0 = 32 * nb;
        const int c = lane & 7;
        f32x4 g0 = (f32x4){1.f, 1.f, 1.f, 1.f}, g1 = g0;
        if (gain) { g0 = *(const f32x4*)(gain + k0 + 8 * c); g1 = *(const f32x4*)(gain + k0 + 8 * c + 4); }
        const float* wp = W + (size_t)(k0 + (lane >> 5)) * ldw + col0 + n0 + (lane & 31);
        float v[32];
#pragma unroll
        for (int i = 0; i < 32; ++i) v[i] = wp[(size_t)(2 * i) * ldw];
#pragma unroll
        for (int i = 0; i < 32; ++i) scr[(2 * i + (lane >> 5)) * 33 + (lane & 31)] = v[i];
        LDS_WAIT();
#pragma unroll
        for (int j = 0; j < 4; ++j) { const int n = (lane >> 3) + 8 * j; const LAS float* s = scr + (8 * c) * 33 + n;
            u32x4 o; o.x = cvt_pk_bf16(s[0 * 33] * g0[0], s[1 * 33] * g0[1]); o.y = cvt_pk_bf16(s[2 * 33] * g0[2], s[3 * 33] * g0[3]);
            o.z = cvt_pk_bf16(s[4 * 33] * g1[0], s[5 * 33] * g1[1]); o.w = cvt_pk_bf16(s[6 * 33] * g1[2], s[7 * 33] * g1[3]);
            *(u32x4*)(WT + (size_t)(n0 + n) * K + k0 + 8 * c) = o; }
        LDS_WAIT();
    }
}

__device__ __forceinline__ void convert_layer(const Params& p, int l, LAS float* scr, int gw, int NGW, int lane) {
    int wz_ = 0; asm volatile("" : "+s"(wz_)); unsigned char* ws = p.ws + wz_;
    bf16_t* WNAT = (bf16_t*)(ws + WS_WNAT); bf16_t* WSWP = (bf16_t*)(ws + WS_WSWP); bf16_t* WOUT = (bf16_t*)(ws + WS_WOUT);
    const float* pg = p.pre_g + (size_t)l * D;
    if (l < 2) {
        const float* W = p.w_in_a + (size_t)l * D * 10240;
        convert_block(W, 10240, 2048, 2048, D, pg, WNAT, scr, gw, NGW, lane);
        convert_block(W, 10240, 6144, 2048, D, pg, WNAT + (size_t)2048 * D, scr, gw, NGW, lane);
        convert_block(W, 10240, 0, 2048, D, pg, WNAT + (size_t)4096 * D, scr, gw, NGW, lane);
        convert_block(W, 10240, 8192, 2048, D, pg, WNAT + (size_t)6144 * D, scr, gw, NGW, lane);
        convert_block(W, 10240, 4096, 2048, D, pg, WSWP + (size_t)2048 * D, scr, gw, NGW, lane);
    } else {
        const float* W = p.w_in_b + (size_t)(l - 2) * D * 6144;
        convert_block(W, 6144, 2048, 2048, D, pg, WNAT, scr, gw, NGW, lane);
        convert_block(W, 6144, 0, 2048, D, pg, WNAT + (size_t)2048 * D, scr, gw, NGW, lane);
        convert_block(W, 6144, 4096, 2048, D, pg, WNAT + (size_t)4096 * D, scr, gw, NGW, lane);
        if (l == 2) {
            convert_block(p.w_kv_b, 512, 0, 256, D, p.kv_g, WNAT + (size_t)6144 * D, scr, gw, NGW, lane);
            convert_block(p.w_kv_b, 512, 256, 256, D, p.kv_g, WSWP, scr, gw, NGW, lane);
        }
    }
    convert_block(p.w_out + (size_t)l * 3072 * D, D, 0, D, 3072, nullptr, WOUT, scr, gw, NGW, lane);
}

__device__ __forceinline__ void norm_row_bf16(const float* xrow, bf16_t* orow, int lane) {
    const f32x4* xr = (const f32x4*)xrow + lane;
    f32x4 v[8]; float s = 0.f;
#pragma unroll
    for (int j = 0; j < 8; ++j) { v[j] = xr[64 * j]; s += (v[j][0] * v[j][0] + v[j][1] * v[j][1]) + (v[j][2] * v[j][2] + v[j][3] * v[j][3]); }
    const float rs = rsqrtf(wave_sum(s, lane) * (1.f / D) + EPS);
    u32x2* o8 = (u32x2*)orow + lane;
#pragma unroll
    for (int j = 0; j < 8; ++j) { u32x2 w; w.x = cvt_pk_bf16(v[j][0] * rs, v[j][1] * rs); w.y = cvt_pk_bf16(v[j][2] * rs, v[j][3] * rs); o8[64 * j] = w; }
}

__device__ __forceinline__ void norm_row2_bf16(const float* xrow, bf16_t* orow, size_t stride, int lane) {
    f32x4 v[2][8]; float s[2] = {0.f, 0.f};
#pragma unroll
    for (int r = 0; r < 2; ++r) { const f32x4* xr = (const f32x4*)(xrow + r * stride) + lane;
#pragma unroll
        for (int j = 0; j < 8; ++j) v[r][j] = xr[64 * j]; }
#pragma unroll
    for (int r = 0; r < 2; ++r) {
#pragma unroll
        for (int j = 0; j < 8; ++j) s[r] += (v[r][j][0] * v[r][j][0] + v[r][j][1] * v[r][j][1]) + (v[r][j][2] * v[r][j][2] + v[r][j][3] * v[r][j][3]);
        const float rs = rsqrtf(wave_sum(s[r], lane) * (1.f / D) + EPS);
        u32x2* o8 = (u32x2*)(orow + r * stride) + lane;
#pragma unroll
        for (int j = 0; j < 8; ++j) { u32x2 w; w.x = cvt_pk_bf16(v[r][j][0] * rs, v[r][j][1] * rs); w.y = cvt_pk_bf16(v[r][j][2] * rs, v[r][j][3] * rs); o8[64 * j] = w; }
    }
}
__device__ __forceinline__ void phase_p0(const Params& p, LAS unsigned char* lds, int tid, int wave, int lane) {
    asm volatile("" : "+v"(lane), "+v"(tid));
    int wz_ = 0; asm volatile("" : "+s"(wz_)); unsigned char* ws = p.ws + wz_;
    const int G = gridDim.x, gw = blockIdx.x * NWAVES + wave, NGW = G * NWAVES;
    const size_t gt = (size_t)blockIdx.x * NTHREADS + tid, NT = (size_t)G * NTHREADS;
    f32x2* tabN = (f32x2*)(ws + WS_TABN); f32x2* swat = (f32x2*)(ws + WS_SWAT);
    for (size_t i = gt; i < (size_t)T * 128; i += NT) { const int tok = (int)(i >> 7), j = (int)(i & 127); float c, s; sincos_f((float)p.pos[tok] * p.inv_ret[j], c, s); tabN[i] = (f32x2){c, s}; }
    for (size_t i = gt; i < (size_t)T * 8; i += NT) { const int tok = (int)(i >> 3), j = (int)(i & 7); float c, s; sincos_f((float)p.pos[tok] * p.inv_swa[j], c, s); swat[i] = (f32x2){c, s}; }
    for (int m = gw; m < 1024; m += NGW) norm_row_bf16(p.mem + (size_t)m * D, (bf16_t*)(ws + WS_MEMN) + (size_t)m * D, lane);
    for (int m = gw; m < T; m += 2 * NGW) norm_row2_bf16(p.x + (size_t)m * D, (bf16_t*)(ws + WS_YN) + (size_t)m * D, (size_t)NGW * D, lane);
    LAS float* scr = (LAS float*)(lds + wave * 16384);
    for (int l = 0; l < 4; ++l) {
        convert_block(p.w_mem_kv + (size_t)l * D * 2048, 2048, 0, 1024, D, p.mem_g + (size_t)l * D, (bf16_t*)(ws + WS_WMK) + (size_t)l * 1024 * D, scr, gw, NGW, lane);
        convert_block(p.w_mem_kv + (size_t)l * D * 2048, 2048, 1024, 1024, D, p.mem_g + (size_t)l * D, (bf16_t*)(ws + WS_WMV) + (size_t)l * 1024 * D, scr, gw, NGW, lane);
    }
    convert_layer(p, 0, scr, gw, NGW, lane);
}

__device__ __forceinline__ void phase_norm(const Params& p, int l, LAS unsigned char* lds, int wave, int lane) {
    asm volatile("" : "+v"(lane));
    int wz_ = 0; asm volatile("" : "+s"(wz_)); unsigned char* ws = p.ws + wz_;
    const int gw = blockIdx.x * NWAVES + wave, NGW = gridDim.x * NWAVES;
    const bf16_t* OUTH = (const bf16_t*)(ws + WS_OUTF); bf16_t* YN = (bf16_t*)(ws + WS_YN);
    const float* hin = ((l == 0) ? p.x : p.out) + wz_; float* hout = p.out + wz_;
    f32x4 pg[8];
#pragma unroll
    for (int j = 0; j < 8; ++j) pg[j] = *((const f32x4*)(p.post_g + wz_ + (size_t)l * D) + lane + 64 * j);
    for (int m0 = gw; m0 < T; m0 += 2 * NGW) {
        f32x4 o[2][8], h[2][8];
#pragma unroll
        for (int r = 0; r < 2; ++r) { const int m = m0 + r * NGW;
            const u32x2* orow = (const u32x2*)(OUTH + (size_t)m * D) + lane; const f32x4* hrow = (const f32x4*)(hin + (size_t)m * D) + lane;
#pragma unroll
            for (int j = 0; j < 8; ++j) { const u32x2 ow = orow[64 * j]; o[r][j] = (f32x4){bflo(ow.x), bfhi(ow.x), bflo(ow.y), bfhi(ow.y)}; h[r][j] = hrow[64 * j]; } }
#pragma unroll
        for (int r = 0; r < 2; ++r) { const int m = m0 + r * NGW;
            float s = 0.f;
#pragma unroll
            for (int j = 0; j < 8; ++j) s += (o[r][j][0] * o[r][j][0] + o[r][j][1] * o[r][j][1]) + (o[r][j][2] * o[r][j][2] + o[r][j][3] * o[r][j][3]);
            const float rs = rsqrtf(wave_sum(s, lane) * (1.f / D) + EPS);
            float s2 = 0.f;
#pragma unroll
            for (int j = 0; j < 8; ++j) { h[r][j] = h[r][j] + o[r][j] * rs * pg[j]; s2 += (h[r][j][0] * h[r][j][0] + h[r][j][1] * h[r][j][1]) + (h[r][j][2] * h[r][j][2] + h[r][j][3] * h[r][j][3]); }
            f32x4* drow = (f32x4*)(hout + (size_t)m * D) + lane;
#pragma unroll
            for (int j = 0; j < 8; ++j) drow[64 * j] = h[r][j];
            if (l < 3) {
                const float rs2 = rsqrtf(wave_sum(s2, lane) * (1.f / D) + EPS);
                u32x2* o8 = (u32x2*)(YN + (size_t)m * D) + lane;
#pragma unroll
                for (int j = 0; j < 8; ++j) { u32x2 w; w.x = cvt_pk_bf16(h[r][j][0] * rs2, h[r][j][1] * rs2); w.y = cvt_pk_bf16(h[r][j][2] * rs2, h[r][j][3] * rs2); o8[64 * j] = w; }
            }
        }
    }
    if (l < 3) convert_layer(p, l + 1, (LAS float*)(lds + wave * 16384), gw, NGW, lane);
}

typedef short v4i16_t __attribute__((ext_vector_type(4)));
__device__ __forceinline__ unsigned mulh2(unsigned a, pg8::f16x2_t z) { const pg8::f16x2_t r = __builtin_bit_cast(pg8::f16x2_t, a) * z; return __builtin_bit_cast(unsigned, r); }
__device__ __forceinline__ v4i16_t lds_tr(const LAS unsigned char* p) { return __builtin_amdgcn_ds_read_tr16_b64_v4i16((LAS v4i16_t*)p); }
__device__ __forceinline__ void scan_unit(const bf16_t* Zk, const bf16_t* KVT, bf16_t* RT, LAS unsigned char* lds, int u, int wave, int lane) {
    asm volatile("" : "+v"(lane));
    const int tid = wave * 64 + lane;
    const int b = u >> 6, h = (u >> 3) & 7, sl = u & 7, fr = lane & 15, fq = lane >> 4;
    const int dk0 = wave * 32, dv0 = sl * 32;
    const float lg = logf(1.f - exp2f(-5.f - (float)h));
    const float gch = expf(lg * 128.f);
    constexpr int KP = 528, KB = 128 * KP;
    const int krow = tid >> 5, kcc = tid & 31;
    const bf16_t* kbase = Zk + (size_t)(b * SEQ + krow) * 8192 + h * 256 + kcc * 8;
    const bf16_t* vbase = KVT + (size_t)(2048 + h * 256 + dv0 + fr) * T + b * SEQ + fq * 8;
    bf16_t* rbase = RT + (size_t)((b * 8 + h) * 32) * 65536 + (size_t)(dv0 + fr) * 256 + dk0 + 4 * fq;
    const int kst = krow * KP + kcc * 16;
    const int ktr = (8 * fq + (fr >> 2)) * KP + dk0 * 2 + (fr & 3) * 8;
    pg8::f16x2_t zz[8];
#pragma unroll
    for (int k = 0; k < 8; ++k) { const _Float16 z = (_Float16)expf(lg * (float)(127 - (krow + 16 * k))); zz[k] = (pg8::f16x2_t){z, z}; }
    f32x4 acc[2][2];
#pragma unroll
    for (int a = 0; a < 2; ++a)
#pragma unroll
        for (int c = 0; c < 2; ++c) acc[a][c] = (f32x4){0.f, 0.f, 0.f, 0.f};
    u32x4 kr[8]; bf16x8 b0[2][4], b1[2][4];
#define SC_LOADK(n_) do { _Pragma("unroll") for (int k_ = 0; k_ < 8; ++k_) kr[k_] = *(const u32x4*)(kbase + (size_t)((n_) * 128 + 16 * k_) * 8192); } while (0)
#define SC_PUTK(buf_) do { _Pragma("unroll") for (int k_ = 0; k_ < 8; ++k_) { const u32x4 s_ = kr[k_]; u32x4 t_; t_.x = mulh2(s_.x, zz[k_]); t_.y = mulh2(s_.y, zz[k_]); t_.z = mulh2(s_.z, zz[k_]); t_.w = mulh2(s_.w, zz[k_]); \
        *(LAS u32x4*)(lds + (buf_) * KB + kst + k_ * 16 * KP) = t_; } } while (0)
#define SC_LOADB(B_, n_) do { _Pragma("unroll") for (int t_ = 0; t_ < 2; ++t_) _Pragma("unroll") for (int k_ = 0; k_ < 4; ++k_) B_[t_][k_] = ldg8(vbase + (size_t)(t_ * 16) * T + (n_) * 128 + k_ * 32); } while (0)
#define SC_STORE(n_) do { _Pragma("unroll") for (int mt_ = 0; mt_ < 2; ++mt_) _Pragma("unroll") for (int nt_ = 0; nt_ < 2; ++nt_) { u32x2 w_; \
        w_.x = cvt_pk_bf16(acc[mt_][nt_][0], acc[mt_][nt_][1]); w_.y = cvt_pk_bf16(acc[mt_][nt_][2], acc[mt_][nt_][3]); \
        *(u32x2*)(rbase + (size_t)(n_) * 65536 + nt_ * 16 * 256 + mt_ * 16) = w_; } } while (0)
#define SC_COMP(buf_, B_) do { \
        _Pragma("unroll") for (int mt_ = 0; mt_ < 2; ++mt_) { bf16x8 A_[4]; \
            _Pragma("unroll") for (int k_ = 0; k_ < 4; ++k_) { \
                const v4i16_t lo_ = lds_tr(lds + (buf_) * KB + ktr + (k_ * 32) * KP + mt_ * 32), hi_ = lds_tr(lds + (buf_) * KB + ktr + (k_ * 32 + 4) * KP + mt_ * 32); \
                A_[k_] = (bf16x8){lo_.x, lo_.y, lo_.z, lo_.w, hi_.x, hi_.y, hi_.z, hi_.w}; } \
            _Pragma("unroll") for (int nt_ = 0; nt_ < 2; ++nt_) { acc[mt_][nt_] = acc[mt_][nt_] * gch; \
                _Pragma("unroll") for (int k_ = 0; k_ < 4; ++k_) acc[mt_][nt_] = mfma16(A_[k_], B_[nt_][k_], acc[mt_][nt_]); } } \
        } while (0)
    SC_LOADK(0); SC_LOADB(b0, 0);
    SC_PUTK(0);
    SC_LOADK(1);
    __syncthreads();
    for (int n = 0; n < 30; n += 2) {
        SC_STORE(n);     SC_LOADB(b1, n + 1); SC_COMP(0, b0); SC_PUTK(1); SC_LOADK(n + 2); __syncthreads();
        SC_STORE(n + 1); SC_LOADB(b0, n + 2); SC_COMP(1, b1); SC_PUTK(0); if (n + 3 <= 30) SC_LOADK(n + 3); __syncthreads();
    }
    SC_STORE(30); SC_COMP(0, b0);
    SC_STORE(31);
    __syncthreads();
#undef SC_LOADK
#undef SC_PUTK
#undef SC_LOADB
#undef SC_STORE
#undef SC_COMP
}

__device__ __forceinline__ void retc_unit(const Params& p, int u, LAS unsigned char* lds, int tid, int wave, int lane) {
    asm volatile("" : "+v"(lane), "+v"(tid));
    int wz_ = 0; asm volatile("" : "+s"(wz_)); unsigned char* ws = p.ws + wz_;
    bf16_t* Z = (bf16_t*)(ws + WS_Z); const bf16_t* KVT = (const bf16_t*)(ws + WS_KVT); const bf16_t* RT = (const bf16_t*)(ws + WS_RT);
    const int b = u >> 8, h = (u >> 5) & 7, n = u & 31, fr = lane & 15, fq = lane >> 4;
    const int tok0 = b * SEQ + n * 128, q0 = wave * 16;
    const float lg = logf(1.f - exp2f(-5.f - (float)h));
    LAS unsigned char* X = lds; LAS unsigned char* Y = lds + REG_B;
    bf16x8 qf[8];
#pragma unroll
    for (int ks = 0; ks < 8; ++ks) qf[ks] = ldg8(Z + (size_t)(tok0 + q0 + fr) * 8192 + 4096 + h * 256 + ks * 32 + fq * 8);
    const unsigned char* rt = (const unsigned char*)(RT + (size_t)((b * 8 + h) * 32 + n) * 65536);
    __syncthreads();
    stage_tile<128, 512, 544>(X, rt, 512, tid);
    stage_tile<128, 512, 544>(Y, rt + 128 * 512, 512, tid);
    __syncthreads();
    f32x4 acc[16];
#pragma unroll
    for (int nt = 0; nt < 16; ++nt) acc[nt] = (f32x4){0.f, 0.f, 0.f, 0.f};
#pragma unroll
    for (int nt = 0; nt < 16; ++nt) {
        const LAS unsigned char* rp = (nt < 8 ? X : Y) + ((nt & 7) * 16 + fr) * 544 + fq * 16;
#pragma unroll
        for (int ks = 0; ks < 8; ++ks) acc[nt] = mfma16(qf[ks], lds8(rp + ks * 64), acc[nt]);
    }
    {
        f32x4 xi;
#pragma unroll
        for (int i = 0; i < 4; ++i) xi[i] = expf(lg * (float)(q0 + 4 * fq + i + 1));
#pragma unroll
        for (int nt = 0; nt < 16; ++nt) acc[nt] = acc[nt] * xi;
    }
    __syncthreads();
    stage_tile<128, 512, 544>(X, (const unsigned char*)(Z + (size_t)tok0 * 8192 + h * 256), 8192 * 2, tid);
    stage_tile<256, 256, 288>(Y, (const unsigned char*)(KVT + (size_t)(2048 + h * 256) * T + tok0), (size_t)T * 2, tid);
    __syncthreads();
    f32x4 s[8];
#pragma unroll
    for (int nt = 0; nt < 8; ++nt) {
        s[nt] = (f32x4){0.f, 0.f, 0.f, 0.f};
        const LAS unsigned char* kp = X + (nt * 16 + fr) * 544 + fq * 16;
#pragma unroll
        for (int ks = 0; ks < 8; ++ks) s[nt] = mfma16(lds8(kp + ks * 64), qf[ks], s[nt]);
    }
    __syncthreads();
    LAS unsigned char* Pw = X + wave * 9216;
    {
        const float lg2 = lg * 1.4426950408889634f; const int qpos = q0 + fr;
#pragma unroll
        for (int nt = 0; nt < 8; ++nt) {
            f32x4 v;
#pragma unroll
            for (int i = 0; i < 4; ++i) { const int d = qpos - (nt * 16 + 4 * fq + i); v[i] = d >= 0 ? s[nt][i] * exp2f(lg2 * (float)d) : 0.f; }
            u32x2 w; w.x = cvt_pk_bf16(v[0], v[1]); w.y = cvt_pk_bf16(v[2], v[3]);
            *(LAS u32x2*)(Pw + fr * 288 + (nt * 16 + 4 * fq) * 2) = w;
        }
    }
    LDS_WAIT();
#pragma unroll
    for (int ks = 0; ks < 4; ++ks) {
        const bf16x8 pf = lds8(Pw + fr * 288 + ks * 64 + fq * 16);
#pragma unroll
        for (int nt = 0; nt < 16; ++nt) acc[nt] = mfma16(pf, lds8(Y + (nt * 16 + fr) * 288 + ks * 64 + fq * 16), acc[nt]);
    }
    u32x4 gvr[8];
#pragma unroll
    for (int k = 0; k < 8; ++k) { const int c = lane + 64 * k, row = c >> 5, cc = c & 31;
        gvr[k] = *(const u32x4*)(Z + (size_t)(tok0 + q0 + row) * 8192 + h * 256 + cc * 8 + 2048); }
    f32x4 ss = (f32x4){0.f, 0.f, 0.f, 0.f};
#pragma unroll
    for (int nt = 0; nt < 16; ++nt) ss = ss + acc[nt] * acc[nt];
#pragma unroll
    for (int o = 1; o < 16; o <<= 1)
#pragma unroll
        for (int i = 0; i < 4; ++i) ss[i] += shx(ss[i], o, lane);
    f32x4 rs;
#pragma unroll
    for (int i = 0; i < 4; ++i) rs[i] = rsqrtf(ss[i] * (1.f / 256.f) + EPS);
    LDS_WAIT();
#pragma unroll
    for (int nt = 0; nt < 16; ++nt)
#pragma unroll
        for (int i = 0; i < 4; ++i) *(LAS unsigned short*)(Pw + (4 * fq + i) * 544 + (nt * 16 + fr) * 2) = f2bf(acc[nt][i] * rs[i]);
    LDS_WAIT();
#pragma unroll
    for (int k = 0; k < 8; ++k) {
        const int c = lane + 64 * k, row = c >> 5, cc = c & 31;
        const u32x4 ov = *(const LAS u32x4*)(Pw + row * 544 + cc * 16);
        const size_t ro = (size_t)(tok0 + q0 + row) * 8192 + h * 256 + cc * 8;
        *(u32x4*)(Z + ro + 4096) = gate8(ov, gvr[k]);
    }
}

__device__ __forceinline__ void memattn_unit(const Params& p, int l, int u, int zld, int qcol0, LAS unsigned char* lds, int tid, int wave, int lane) {
    asm volatile("" : "+v"(lane), "+v"(tid));
    int wz_ = 0; asm volatile("" : "+s"(wz_)); unsigned char* ws = p.ws + wz_;
    bf16_t* Z = (bf16_t*)(ws + WS_Z); const bf16_t* MK = (const bf16_t*)(ws + WS_MK); const bf16_t* MVT = (const bf16_t*)(ws + WS_MVT);
    const int b = u >> 7, hm = (u >> 5) & 3, qb = u & 31, fr = lane & 15, fq = lane >> 4;
    const int tok0 = b * SEQ + qb * 128, q0 = wave * 16, qcol = qcol0 + hm * 256, gcol = qcol + 1024;
    LAS unsigned char* X = lds; LAS unsigned char* Y = lds + REG_B;
    bf16x8 qf[8];
#pragma unroll
    for (int ks = 0; ks < 8; ++ks) qf[ks] = ldg8(Z + (size_t)(tok0 + q0 + fr) * zld + qcol + ks * 32 + fq * 8);
    const unsigned char* mk = (const unsigned char*)(MK + (size_t)(b * 256) * 4096 + l * 1024 + hm * 256);
    const unsigned char* mv = (const unsigned char*)(MVT + (size_t)(l * 1024 + hm * 256) * 1024 + b * 256);
    __syncthreads();
    stage_tile<128, 512, 544>(X, mk, 4096 * 2, tid);
    stage_tile<128, 512, 544>(Y, mk + (size_t)128 * 4096 * 2, 4096 * 2, tid);
    __syncthreads();
    f32x4 s[16];
#pragma unroll
    for (int nt = 0; nt < 16; ++nt) {
        s[nt] = (f32x4){0.f, 0.f, 0.f, 0.f};
        const LAS unsigned char* kp = (nt < 8 ? X : Y) + ((nt & 7) * 16 + fr) * 544 + fq * 16;
#pragma unroll
        for (int ks = 0; ks < 8; ++ks) s[nt] = mfma16(lds8(kp + ks * 64), qf[ks], s[nt]);
    }
    float mx = -3.0e38f;
#pragma unroll
    for (int nt = 0; nt < 16; ++nt)
#pragma unroll
        for (int i = 0; i < 4; ++i) mx = fmaxf(mx, s[nt][i]);
    mx = fmaxf(mx, shx(mx, 16, lane)); mx = fmaxf(mx, shx(mx, 32, lane));
    float sum = 0.f;
#pragma unroll
    for (int nt = 0; nt < 16; ++nt)
#pragma unroll
        for (int i = 0; i < 4; ++i) { s[nt][i] = __expf((s[nt][i] - mx) * 0.0625f); sum += s[nt][i]; }
    sum += shx(sum, 16, lane); sum += shx(sum, 32, lane);
    const float inv = 1.f / sum;
    __syncthreads();
    LAS unsigned char* Pw = Y + wave * 9216;
#pragma unroll
    for (int nt = 0; nt < 16; ++nt) { u32x2 w; w.x = cvt_pk_bf16(s[nt][0] * inv, s[nt][1] * inv); w.y = cvt_pk_bf16(s[nt][2] * inv, s[nt][3] * inv);
        *(LAS u32x2*)(Pw + fr * 544 + (nt * 16 + 4 * fq) * 2) = w; }
    stage_tile<128, 512, 544>(X, mv, 1024 * 2, tid);
    __syncthreads();
    f32x4 acc[16];
#pragma unroll
    for (int nt = 0; nt < 16; ++nt) acc[nt] = (f32x4){0.f, 0.f, 0.f, 0.f};
#pragma unroll
    for (int ks = 0; ks < 8; ++ks) {
        const bf16x8 pf = lds8(Pw + fr * 544 + ks * 64 + fq * 16);
#pragma unroll
        for (int nt = 0; nt < 8; ++nt) acc[nt] = mfma16(pf, lds8(X + (nt * 16 + fr) * 544 + ks * 64 + fq * 16), acc[nt]);
    }
    __syncthreads();
    stage_tile<128, 512, 544>(X, mv + (size_t)128 * 1024 * 2, 1024 * 2, tid);
    __syncthreads();
#pragma unroll
    for (int ks = 0; ks < 8; ++ks) {
        const bf16x8 pf = lds8(Pw + fr * 544 + ks * 64 + fq * 16);
#pragma unroll
        for (int nt = 0; nt < 8; ++nt) acc[8 + nt] = mfma16(pf, lds8(X + (nt * 16 + fr) * 544 + ks * 64 + fq * 16), acc[8 + nt]);
    }
    u32x4 gvm[8];
#pragma unroll
    for (int k = 0; k < 8; ++k) { const int c = lane + 64 * k, row = c >> 5, cc = c & 31;
        gvm[k] = *(const u32x4*)(Z + (size_t)(tok0 + q0 + row) * zld + gcol + cc * 8); }
    LDS_WAIT();
#pragma unroll
    for (int nt = 0; nt < 16; ++nt)
#pragma unroll
        for (int i = 0; i < 4; ++i) *(LAS unsigned short*)(Pw + (4 * fq + i) * 544 + (nt * 16 + fr) * 2) = f2bf(acc[nt][i]);
    LDS_WAIT();
#pragma unroll
    for (int k = 0; k < 8; ++k) {
        const int c = lane + 64 * k, row = c >> 5, cc = c & 31;
        const u32x4 ov = *(const LAS u32x4*)(Pw + row * 544 + cc * 16);
        const size_t ro = (size_t)(tok0 + q0 + row) * zld;
        *(u32x4*)(Z + ro + qcol + cc * 8) = gate8(ov, gvm[k]);
    }
}

__device__ __forceinline__ void swa_unit(const Params& p, int lb, int u, LAS unsigned char* lds, int tid, int wave, int lane) {
    asm volatile("" : "+v"(lane), "+v"(tid));
    int wz_ = 0; asm volatile("" : "+s"(wz_)); unsigned char* ws = p.ws + wz_;
    bf16_t* Z = (bf16_t*)(ws + WS_Z); const bf16_t* KS = (const bf16_t*)(ws + WS_KS); const bf16_t* VST = (const bf16_t*)(ws + WS_VST);
    const int b = u >> 7, kvh = (u >> 5) & 3, n = u & 31, fr = lane & 15, fq = lane >> 4;
    const int tok0 = b * SEQ + n * 128, hq = kvh * 8 + wave;
    const float sink = p.sinks[lb * 32 + hq];
    LAS unsigned char* X = lds; LAS unsigned char* Y = lds + 40960; LAS unsigned char* Pw = lds + 75776 + wave * 8704;
    __syncthreads();
    {
#pragma unroll
        for (int k = 0; k < 4; ++k) { const int c = tid + k * NTHREADS, r = c >> 3, cc = c & 7; u32x4 v = (u32x4){0u, 0u, 0u, 0u};
            if (n > 0 || r >= 128) v = *(const u32x4*)(KS + (size_t)(tok0 - 128 + r) * 256 + kvh * 64 + cc * 8);
            *(LAS u32x4*)(X + r * 160 + cc * 16) = v; }
#pragma unroll
        for (int k = 0; k < 4; ++k) { const int c = tid + k * NTHREADS, r = c >> 5, cc = c & 31; u32x4 v = (u32x4){0u, 0u, 0u, 0u};
            if (n > 0 || cc >= 16) v = *(const u32x4*)(VST + (size_t)(kvh * 64 + r) * T + tok0 - 128 + cc * 8);
            *(LAS u32x4*)(Y + r * 544 + cc * 16) = v; }
    }
    __syncthreads();
    for (int mt = 0; mt < 8; ++mt) {
        bf16x8 qf[2];
#pragma unroll
        for (int ks = 0; ks < 2; ++ks) qf[ks] = ldg8(Z + (size_t)(tok0 + mt * 16 + fr) * 6144 + 2048 + hq * 64 + ks * 32 + fq * 8);
        u32x4 gvs[2];
#pragma unroll
        for (int k = 0; k < 2; ++k) { const int c = lane + 64 * k, row = c >> 3, cc = c & 7; gvs[k] = *(const u32x4*)(Z + (size_t)(tok0 + mt * 16 + row) * 6144 + hq * 64 + cc * 8); }
        f32x4 s[16];
#pragma unroll
        for (int nt = 0; nt < 16; ++nt) {
            s[nt] = (f32x4){0.f, 0.f, 0.f, 0.f};
#pragma unroll
            for (int ks = 0; ks < 2; ++ks) s[nt] = mfma16(lds8(X + (nt * 16 + fr) * 160 + ks * 64 + fq * 16), qf[ks], s[nt]);
        }
        const int iq = mt * 16 + fr;
        float mx = -3.0e38f;
#pragma unroll
        for (int nt = 0; nt < 16; ++nt)
#pragma unroll
            for (int i = 0; i < 4; ++i) { const int jk = nt * 16 + 4 * fq + i, rel = iq + 128 - jk; const bool valid = rel >= 0 && rel < 128 && (n > 0 || jk >= 128);
                s[nt][i] = valid ? s[nt][i] * 0.125f : -1e30f; mx = fmaxf(mx, s[nt][i]); }
        mx = fmaxf(mx, shx(mx, 16, lane)); mx = fmaxf(mx, shx(mx, 32, lane));
        mx = fmaxf(mx, sink);
        float sum = 0.f;
#pragma unroll
        for (int nt = 0; nt < 16; ++nt)
#pragma unroll
            for (int i = 0; i < 4; ++i) { s[nt][i] = __expf(s[nt][i] - mx); sum += s[nt][i]; }
        sum += shx(sum, 16, lane); sum += shx(sum, 32, lane);
        const float inv = 1.f / (sum + __expf(sink - mx));
#pragma unroll
        for (int nt = 0; nt < 16; ++nt) { u32x2 w; w.x = cvt_pk_bf16(s[nt][0] * inv, s[nt][1] * inv); w.y = cvt_pk_bf16(s[nt][2] * inv, s[nt][3] * inv);
            *(LAS u32x2*)(Pw + fr * 544 + (nt * 16 + 4 * fq) * 2) = w; }
        LDS_WAIT();
        f32x4 acc[4];
#pragma unroll
        for (int nt = 0; nt < 4; ++nt) acc[nt] = (f32x4){0.f, 0.f, 0.f, 0.f};
#pragma unroll
        for (int ks = 0; ks < 8; ++ks) {
            const bf16x8 pf = lds8(Pw + fr * 544 + ks * 64 + fq * 16);
#pragma unroll
            for (int nt = 0; nt < 4; ++nt) acc[nt] = mfma16(pf, lds8(Y + (nt * 16 + fr) * 544 + ks * 64 + fq * 16), acc[nt]);
        }
        LDS_WAIT();
#pragma unroll
        for (int nt = 0; nt < 4; ++nt)
#pragma unroll
            for (int i = 0; i < 4; ++i) *(LAS unsigned short*)(Pw + (4 * fq + i) * 160 + (nt * 16 + fr) * 2) = f2bf(acc[nt][i]);
        LDS_WAIT();
#pragma unroll
        for (int k = 0; k < 2; ++k) {
            const int c = lane + 64 * k, row = c >> 3, cc = c & 7;
            const u32x4 ov = *(const LAS u32x4*)(Pw + row * 160 + cc * 16);
            const size_t ro = (size_t)(tok0 + mt * 16 + row) * 6144 + hq * 64 + cc * 8;
            *(u32x4*)(Z + ro + 2048) = gate8(ov, gvs[k]);
        }
        LDS_WAIT();
    }
}

__device__ __forceinline__ void l2_flush_part(const float* base, size_t wg_bytes, int iters, int bid, int tid) {
    const u32x4* src = (const u32x4*)((const unsigned char*)base + (size_t)bid * wg_bytes) + tid;
    unsigned a = 0;
#pragma unroll 1
    for (int i0 = 0; i0 < iters; i0 += 8) {
        u32x4 v[8];
#pragma unroll
        for (int i = 0; i < 8; ++i) v[i] = src[(i0 + i) * 512];
#pragma unroll
        for (int i = 0; i < 8; ++i) a ^= v[i].x ^ v[i].y ^ v[i].z ^ v[i].w;
        asm volatile("s_waitcnt vmcnt(0)" ::: "memory");
#pragma unroll
        for (int i = 0; i < 8; ++i) a ^= (unsigned)__hip_atomic_load((const unsigned long long*)(src + (i0 + i) * 512), __ATOMIC_RELAXED, __HIP_MEMORY_SCOPE_AGENT);
    }
    asm volatile("" :: "v"(a));
}
__device__ __forceinline__ void l2_flush(const Params& p, int bid, int tid) {
    l2_flush_part(p.x, 262144, 32, bid, tid);
}

#define XB_TMO      128
#define XB_XCNT(j)  (256  + 64 * (j))
#define XB_XSUB(j)  (1280 + 64 * (j))
#define XB_XGEN(j)  (2304 + 64 * (j))
#define XB_TOP      3328
#define XB_TOPGEN   3392
#define XCD_BAR_WORDS 3456
#define XB_SPIN_CAP (1u << 18)
__device__ __forceinline__ unsigned xb_ld(unsigned* p)              { return __hip_atomic_load(p, __ATOMIC_RELAXED, __HIP_MEMORY_SCOPE_AGENT); }
__device__ __forceinline__ unsigned xb_add(unsigned* p, unsigned v) { return __hip_atomic_fetch_add(p, v, __ATOMIC_RELAXED, __HIP_MEMORY_SCOPE_AGENT); }
__device__ __forceinline__ unsigned xb_xcc_id() { return (unsigned)__builtin_amdgcn_s_getreg((3 << 11) | 20) & 0xFu; }
#define XB_SPIN(cond, bar) do { unsigned _sp = 0; while (cond) { __builtin_amdgcn_s_sleep(1); \
    if ((++_sp & 255u) == 0u) { if (xb_ld(&(bar)[XB_TMO])) break; if (_sp > XB_SPIN_CAP) { atomicAdd(&(bar)[XB_TMO], 1u); break; } } } } while (0)
struct XcdBarrier { unsigned* bar; unsigned x; volatile LAS unsigned* st; };
__device__ __forceinline__ void xcd_barrier_complete(unsigned* bar, unsigned x, unsigned& nloc, unsigned& nx) {
    const unsigned G = gridDim.x * gridDim.y * gridDim.z;
    unsigned sum, cnt, mine, sp = 0u;
    for (;;) {
        sum = 0u; cnt = 0u; mine = 0u;
#pragma unroll
        for (unsigned j = 0; j < 16; ++j) { const unsigned c = xb_ld(&bar[XB_XCNT(j)]); sum += c; cnt += (c > 0u) ? 1u : 0u; mine = (j == x) ? c : mine; }
        if (sum == G) break;
        __builtin_amdgcn_s_sleep(1);
        if ((++sp & 255u) == 0u) { if (xb_ld(&bar[XB_TMO])) break; if (sp > XB_SPIN_CAP) { atomicAdd(&bar[XB_TMO], 1u); break; } }
    }
    nloc = mine > 0u ? mine : 1u; nx = cnt > 0u ? cnt : 1u;
}
__device__ __forceinline__ void xcd_barrier(const XcdBarrier& b) {
    asm volatile("s_waitcnt vmcnt(0)" ::: "memory");
    __syncthreads();
    if (threadIdx.x == 0) {
        unsigned* bar = b.bar;
        __builtin_amdgcn_s_waitcnt(0);
        unsigned nloc = b.st[0], nx = b.st[1];
        if (nloc == 0u) { xcd_barrier_complete(bar, b.x, nloc, nx); b.st[0] = nloc; b.st[1] = nx; }
        const unsigned old = xb_add(&bar[XB_XSUB(b.x)], 1u);
        const unsigned gen = old / nloc;
        if (old + 1u == (gen + 1u) * nloc) {
            __builtin_amdgcn_fence(__ATOMIC_RELEASE, "agent");
            asm volatile("s_waitcnt vmcnt(0)" ::: "memory");
            const unsigned og = xb_add(&bar[XB_TOP], 1u);
            const unsigned tg = og / nx;
            if (og + 1u == (tg + 1u) * nx) xb_add(&bar[XB_TOPGEN], 1u);
            else XB_SPIN(xb_ld(&bar[XB_TOPGEN]) == tg, bar);
            __builtin_amdgcn_fence(__ATOMIC_ACQUIRE, "agent");
            xb_add(&bar[XB_XGEN(b.x)], 1u);
            asm volatile("s_waitcnt vmcnt(0)" ::: "memory");
        } else {
            XB_SPIN(xb_ld(&bar[XB_XGEN(b.x)]) == gen, bar);
            __builtin_amdgcn_fence(__ATOMIC_ACQUIRE, "agent");
            asm volatile("s_waitcnt vmcnt(0)" ::: "memory");
        }
    }
    __syncthreads();
}
__global__ void __launch_bounds__(NTHREADS, 2) yoco_fwd(Params p) {
    extern __shared__ __attribute__((aligned(16))) unsigned char lds_raw[];
    LAS unsigned char* lds = (LAS unsigned char*)lds_raw;
    const int tid = threadIdx.x, lane = tid & 63, wave = __builtin_amdgcn_readfirstlane(tid >> 6);
    const int G = gridDim.x, bid = blockIdx.x;
    const int lo = p.ph_lo, hi = p.ph_hi;
    int ph = 0;
    int xrank;
    XcdBarrier xbar;
    {
        LAS unsigned* slot = (LAS unsigned*)(lds + 147456);
        xbar.bar = (unsigned*)(p.ws + 16384); xbar.x = xb_xcc_id(); xbar.st = (volatile LAS unsigned*)(lds + 147456 + 16);
        if (tid == 0) { slot[0] = xb_add(&xbar.bar[XB_XCNT(xbar.x)], 1u); slot[4] = 0u; slot[5] = 0u; }
        __syncthreads();
        xrank = __builtin_amdgcn_readfirstlane((int)(slot[0] & 31u));
        __syncthreads();
    }
#define IN_PH() (ph >= lo && ph < hi)
#if MK_SINGLE
#define SEAM(FL) do { if (ph >= lo && ph + 1 < hi) { asm volatile("s_waitcnt vmcnt(0)" ::: "memory"); if (FL) { l2_flush(p, xrank, tid); asm volatile("s_waitcnt vmcnt(0)" ::: "memory"); } if (lo < 0) cg::this_grid().sync();     xcd_barrier(xbar); } ++ph; } while (0)
#else
#define SEAM(FL) do { ++ph; } while (0)
#endif
#define LOCAL_PTRS() int wz_ = 0; asm volatile("" : "+s"(wz_)); unsigned char* ws = p.ws + wz_; \
    bf16_t* YN = (bf16_t*)(ws + WS_YN); bf16_t* Z = (bf16_t*)(ws + WS_Z); bf16_t* WNAT = (bf16_t*)(ws + WS_WNAT); bf16_t* WSWP = (bf16_t*)(ws + WS_WSWP); bf16_t* WOUT = (bf16_t*)(ws + WS_WOUT); \
    (void)YN; (void)Z; (void)WNAT; (void)WSWP; (void)WOUT

    if (EN(0) && IN_PH()) phase_p0(p, lds, tid, wave, lane);
    SEAM(true);

    for (int l = 0; l < 4; ++l) {
        const bool isA = l < 2;
        if (IN_PH()) {
            LOCAL_PTRS();
            if (isA) {
                if (EN(1)) { pg8::Gemm g{YN, WNAT, T, 8192, D, D, D}; pg8::StaticOrder S; S.init(T, 8192, G, bid);
                  EpiNat E{Z, 8192, 16, (const f32x4*)(ws + WS_TABN), 0, -1, nullptr, nullptr};
                  pg8::gemm_phase<EpiNat, true>(lds, g, S, E); }
                if (EN(2)) { pg8::Gemm g{WSWP + (size_t)2048 * D, YN, 2048, T, D, D, D}; pg8::StaticOrder S; S.init(2048, T, G, bid);
                  EpiSwp E{(bf16_t*)(ws + WS_KVT) + (size_t)2048 * T, T, 0, nullptr, nullptr};
                  pg8::gemm_phase<EpiSwp, true>(lds, g, S, E); }
                if (EN(3) && l == 0) {
                    { pg8::Gemm g{(const bf16_t*)(ws + WS_MEMN), (const bf16_t*)(ws + WS_WMK), 1024, 4096, D, D, D}; pg8::StaticOrder S; S.init(1024, 4096, G, bid);
                      EpiNat E{(bf16_t*)(ws + WS_MK), 4096, 0, nullptr, 0, -1, nullptr, nullptr};
                      pg8::gemm_phase<EpiNat, true>(lds, g, S, E); }
                    { pg8::Gemm g{(const bf16_t*)(ws + WS_WMV), (const bf16_t*)(ws + WS_MEMN), 4096, 1024, D, D, D}; pg8::StaticOrder S; S.init(4096, 1024, G, (bid + 192) & 255);
                      EpiSwp E{(bf16_t*)(ws + WS_MVT), 1024, 0, nullptr, nullptr};
                      pg8::gemm_phase<EpiSwp, true>(lds, g, S, E); }
                }
            } else if (EN(4)) {
                const int N = (l == 2) ? 6400 : 6144;
                { pg8::Gemm g{YN, WNAT, T, N, D, D, D}; pg8::StaticOrder S; S.init(T, N, G, bid);
                  EpiNat E{Z, 6144, 0, nullptr, 8, (l == 2) ? 24 : -1, (bf16_t*)(ws + WS_KS), (const f32x4*)(ws + WS_SWAT)};
                  pg8::gemm_phase<EpiNat, true>(lds, g, S, E); }
                if (l == 2) {
                    pg8::Gemm g{WSWP, YN, 256, T, D, D, D}; pg8::StaticOrder S; S.init(256, T, G, (bid + 192) & 255);
                    EpiSwp E{(bf16_t*)(ws + WS_VST), T, 0, nullptr, nullptr};
                    pg8::gemm_phase<EpiSwp, true>(lds, g, S, E);
                }
            }
        }
        SEAM(true);
        if (isA) {
            if (IN_PH()) {
                LOCAL_PTRS();
                if (EN(5)) { __syncthreads(); for (int u = bid; u < 256; u += G) scan_unit(Z, (const bf16_t*)(ws + WS_KVT), (bf16_t*)(ws + WS_RT), lds, u, wave, lane); }
                if (EN(6)) for (int u = bid; u < 512; u += G) memattn_unit(p, l, u, 8192, 6144, lds, tid, wave, lane);
            }
            SEAM(true);
            if (EN(7) && IN_PH()) { for (int u = bid; u < 1024; u += G) retc_unit(p, u, lds, tid, wave, lane); }
            SEAM(false);
        } else {
            if (IN_PH()) {
                if (EN(8)) for (int u = bid; u < 512; u += G) swa_unit(p, l - 2, u, lds, tid, wave, lane);
                if (EN(6)) for (int u = bid; u < 512; u += G) memattn_unit(p, l, u, 6144, 4096, lds, tid, wave, lane);
            }
            SEAM(true);
        }
        if (EN(9) && IN_PH()) {
            LOCAL_PTRS();
            __syncthreads();
            pg8::StaticOrder S; S.init(T, D, G, bid);
            EpiNat E{(bf16_t*)(ws + WS_OUTF), D, 0, nullptr, 0, -1, nullptr, nullptr};
            if (isA) { pg8::Gemm g{Z + 4096, WOUT, T, D, 3072, 8192, 3072}; pg8::gemm_phase<EpiNat, true>(lds, g, S, E); }
            else     { pg8::Gemm g{Z + 2048, WOUT, T, D, 3072, 6144, 3072}; pg8::gemm_phase<EpiNat, true>(lds, g, S, E); }
        }
        SEAM(isA);
        if (EN(10) && IN_PH()) { __syncthreads(); phase_norm(p, l, lds, wave, lane); }
        SEAM(false);
    }
}
constexpr int N_PHASES = 1 + 2 * 5 + 2 * 4;
#ifndef PROBE_PH
#define PROBE_PH -1
#endif
#ifndef PROBE_OFF
#define PROBE_OFF WS_Z
#endif
__global__ void probe_copy(const bf16_t* src, float* out, size_t n) {
    for (size_t i = (size_t)blockIdx.x * blockDim.x + threadIdx.x; i < n; i += (size_t)gridDim.x * blockDim.x) out[i] = bf2f(src[i]);
}

extern "C" void kernel_launch(void* const* d_in, const int* in_sizes, int n_in, void* d_out, int out_size, void* d_ws, size_t ws_size, hipStream_t stream) {
    static int grid = 0;
    if (grid == 0) {
        if (n_in != 13 || ws_size < WS_END) { fprintf(stderr, "kernel_launch: unexpected n_in %d or ws_size %zu (< %zu)\n", n_in, ws_size, (size_t)WS_END); grid = -1; return; }
        if (hipFuncSetAttribute((const void*)yoco_fwd, hipFuncAttributeMaxDynamicSharedMemorySize, LDS_BYTES) != hipSuccess) { fprintf(stderr, "kernel_launch: hipFuncSetAttribute failed\n"); grid = -1; return; }
        int dev = 0, cus = 0, per_cu = 0;
        (void)hipGetDevice(&dev); (void)hipDeviceGetAttribute(&cus, hipDeviceAttributeMultiprocessorCount, dev);
        (void)hipOccupancyMaxActiveBlocksPerMultiprocessor(&per_cu, (const void*)yoco_fwd, NTHREADS, LDS_BYTES);
        if (per_cu < 1) { fprintf(stderr, "kernel_launch: occupancy query says %d blocks per CU\n", per_cu); per_cu = 1; }
        (void)hipGetLastError();
        grid = cus;
    }
    if (grid < 0) return;
    Params p{};
    p.x = (const float*)d_in[0]; p.mem = (const float*)d_in[1]; p.pos = (const int*)d_in[2]; p.pre_g = (const float*)d_in[3]; p.post_g = (const float*)d_in[4];
    p.mem_g = (const float*)d_in[5]; p.kv_g = (const float*)d_in[6]; p.w_in_a = (const float*)d_in[7]; p.w_in_b = (const float*)d_in[8]; p.w_kv_b = (const float*)d_in[9];
    p.sinks = (const float*)d_in[10]; p.w_mem_kv = (const float*)d_in[11]; p.w_out = (const float*)d_in[12];
    p.out = (float*)d_out; p.ws = (unsigned char*)d_ws;
    for (int j = 0; j < 128; ++j) p.inv_ret[j] = (float)pow(10000.0, -(double)(2 * j) / 256.0);
    for (int j = 0; j < 8; ++j) p.inv_swa[j] = (float)pow(500000.0, -(double)(2 * j) / 16.0);
#if MK_SINGLE
    p.ph_lo = 0; p.ph_hi = N_PHASES;
    (void)hipMemsetAsync(d_ws, 0, 32768, stream);
    void* args[] = {&p};
    hipError_t e = hipLaunchCooperativeKernel((const void*)yoco_fwd, dim3(grid), dim3(NTHREADS), args, LDS_BYTES, stream);
    if (e != hipSuccess) fprintf(stderr, "kernel_launch: cooperative launch failed: %s (grid %d)\n", hipGetErrorString(e), grid);
#else
    for (int ph = 0; ph < N_PHASES; ++ph) {
        p.ph_lo = ph; p.ph_hi = ph + 1;
        hipLaunchKernelGGL(yoco_fwd, dim3(grid), dim3(NTHREADS), LDS_BYTES, stream, p);
#ifdef SNAP_PH
        if (ph == SNAP_PH) (void)hipMemcpyAsync((unsigned char*)d_ws + 626 * MiB, (unsigned char*)d_ws + SNAP_OFF, 14 * MiB, hipMemcpyDeviceToDevice, stream);
#endif
#ifdef STOP_PH
        if (ph == STOP_PH) break;
#endif
#ifdef SNAP_PH
        if (ph == N_PHASES - 1) { (void)hipMemsetAsync(d_out, 0, (size_t)T * D * 4, stream);
            hipLaunchKernelGGL(probe_copy, dim3(2048), dim3(256), 0, stream, (const bf16_t*)((unsigned char*)d_ws + 626 * MiB), (float*)d_out, (size_t)7 * 1024 * 1024); }
#endif
        if (ph == PROBE_PH) { hipLaunchKernelGGL(probe_copy, dim3(2048), dim3(256), 0, stream, (const bf16_t*)((unsigned char*)d_ws + PROBE_OFF), (float*)d_out, (size_t)T * D); break; }
    }
#endif
}
```

```cpp
#include <hip/hip_runtime.h>
#include <hip/hip_cooperative_groups.h>
#include <cstdio>
#include <cstdint>
#include <cmath>
namespace cg = cooperative_groups;

#ifndef MK_SINGLE
#define MK_SINGLE 1
#endif

#ifndef EN_MASK
#define EN_MASK 0xFFFF
#endif
#define EN(b) ((EN_MASK >> (b)) & 1)
#define LAS __attribute__((address_space(3)))
typedef unsigned short bf16_t;
typedef short bf16x8 __attribute__((ext_vector_type(8)));
typedef float f32x4 __attribute__((ext_vector_type(4)));
typedef float f32x2 __attribute__((ext_vector_type(2)));
typedef unsigned u32x4 __attribute__((ext_vector_type(4)));
typedef unsigned u32x2 __attribute__((ext_vector_type(2)));

constexpr int T = 16384, D = 2048, SEQ = 4096;
constexpr float EPS = 1e-6f;
constexpr int NTHREADS = 512, NWAVES = 8;

constexpr size_t MiB = 1u << 20;
constexpr size_t WS_TABN = 1 * MiB;
constexpr size_t WS_COST = 17 * MiB;
constexpr size_t WS_SINT = 25 * MiB;
constexpr size_t WS_KS   = 1 * MiB;
constexpr size_t WS_VST  = 9 * MiB;
constexpr size_t WS_SWAT = 33 * MiB;
constexpr size_t WS_MEMN = 34 * MiB;
constexpr size_t WS_MK   = 38 * MiB;
constexpr size_t WS_MVT  = 46 * MiB;
constexpr size_t WS_WNAT = 54 * MiB;
constexpr size_t WS_WSWP = 86 * MiB;
constexpr size_t WS_WOUT = 102 * MiB;
constexpr size_t WS_Z    = 114 * MiB;
constexpr size_t WS_KVT  = 370 * MiB;
constexpr size_t WS_OUTF = 370 * MiB;
constexpr size_t WS_RT   = 498 * MiB;
constexpr size_t WS_YN   = 498 * MiB;
constexpr size_t WS_WMK  = 562 * MiB;
constexpr size_t WS_WMV  = 578 * MiB;
constexpr size_t WS_END  = 626 * MiB;

constexpr int LDS_BYTES = 147456 + 64;
constexpr int REG_B = 73728;

struct Params {
    const float* x; const float* mem; const int* pos; const float* pre_g; const float* post_g; const float* mem_g; const float* kv_g;
    const float* w_in_a; const float* w_in_b; const float* w_kv_b; const float* sinks; const float* w_mem_kv; const float* w_out;
    float* out; unsigned char* ws; int ph_lo, ph_hi;
    float inv_ret[128]; float inv_swa[8];
};

namespace pg8 {
constexpr int BM = 256, BK = 64, HALF = 128, HTB = HALF * BK * 2, STAGE_BYTES = 8 * HTB, NXCD = 8, WGM = 8;
__host__ __device__ __forceinline__ int lds_byte(int r, int c) { const int st = (r >> 4) * 2 + (c >> 5), rr = r & 15, cc = c & 31, ob = rr * 64 + cc * 2; return st * 1024 + (ob ^ (((ob >> 9) & 1) << 5)); }
__host__ __device__ __forceinline__ void stage_rc(int b, int& R, int& C) { const int st = b / 1024, sb = b % 1024, swz = sb ^ (((sb >> 9) & 1) << 5); R = (st >> 1) * 16 + swz / 64; C = (st & 1) * 32 + (swz % 64) / 2; }
__host__ __device__ __forceinline__ int perm32(int rho) { const int n = rho >> 4, i = rho & 15; return 8 * (i >> 2) + 4 * n + (i & 3); }

struct Unit { int pm, pn; };
struct Gemm { const bf16_t* A; const bf16_t* Bt; int M, N, K, lda, ldb; };

struct StaticOrder {
    int nM, nN, nwg, G, c;
    __host__ __device__ void init(int M, int N, int G_, int c_) { nM = M / BM; nN = N / BM; nwg = nM * nN; G = G_; c = c_; }
    __host__ __device__ bool next(int i, Unit& u) const {
        const long L = (long)i * G + c; if (L >= nwg) return false;
        int wgid = (int)L; { const int q = nwg / NXCD, r = nwg % NXCD, xcd = wgid % NXCD, off = wgid / NXCD; wgid = (xcd < r ? xcd * (q + 1) : r * (q + 1) + (xcd - r) * q) + off; }
        const int nig = WGM * nN, gid = wgid / nig, fm = gid * WGM, gsz = (nM - fm) < WGM ? (nM - fm) : WGM;
        u.pm = fm + ((wgid % nig) % gsz); u.pn = (wgid % nig) / gsz; return true;
    }
};

typedef _Float16 f16x2_t __attribute__((ext_vector_type(2)));
typedef _Float16 f16x8_t __attribute__((ext_vector_type(8)));
__device__ __forceinline__ unsigned cvt_pk_bf16(float lo, float hi) { const f16x2_t v = {(_Float16)lo, (_Float16)hi}; return __builtin_bit_cast(unsigned, v); }

template <class Epi, bool ALIGN_EPI>
__device__ __forceinline__ void gemm_phase(LAS unsigned char* lds, const Gemm g_in, const StaticOrder& S, const Epi& E) {
    Gemm g = g_in;
    { const bf16_t* a_ = g.A; const bf16_t* b_ = g.Bt; asm volatile("" : "+s"(a_), "+s"(b_)); g.A = a_; g.Bt = b_; }
    int tid = threadIdx.x; asm volatile("" : "+v"(tid));
    const int wid = __builtin_amdgcn_readfirstlane(tid >> 6), lane = tid & 63, wr = wid >> 2, wc = wid & 3, fr = lane & 15, fq = lane >> 4;
    const int K = g.K, nt = K / BK;
    unsigned voffA[2], voffB[2];
#pragma unroll
    for (int i = 0; i < 2; ++i) { int R, C; stage_rc(tid * 16 + i * 8192, R, C); const int Rb = Epi::PERM ? ((R & ~31) + perm32(R & 31)) : R;
        voffA[i] = (unsigned)(R * g.lda + C) * 2u; voffB[i] = (unsigned)(Rb * g.ldb + C) * 2u; }
    const size_t kstep = (size_t)(BK * 2);
    const size_t hstepA = (size_t)HALF * g.lda * 2, hstepB = (size_t)HALF * g.ldb * 2;
    const size_t tstepA = 2 * hstepA, tstepB = 2 * hstepB;
    const unsigned ldsw = (unsigned)wid * 1024u;
    const int aoff = lds_byte(wr * 64 + fr, fq * 8), boff = lds_byte(wc * 32 + fr, fq * 8);
#define PG8_SA(b, h) (((b) * 2 + (h)) * HTB)
#define PG8_SB(b, h) ((4 + (b) * 2 + (h)) * HTB)
#define PG8_STAGE(bufoff, gbase, voff) do { _Pragma("unroll") for (int _i = 0; _i < 2; ++_i) \
        __builtin_amdgcn_global_load_lds((const unsigned*)((const char*)(gbase) + (voff)[_i]), (LAS unsigned*)(lds + (bufoff) + ldsw + _i * 8192), 16, 0, 0); } while (0)
#define PG8_LDA(dst, b, h) do { _Pragma("unroll") for (int m = 0; m < 4; ++m) _Pragma("unroll") for (int k = 0; k < 2; ++k) dst[m][k] = *(const LAS bf16x8*)(lds + PG8_SA(b, h) + aoff + m * 2048 + k * 1024); } while (0)
#define PG8_LDB(dst, b, h) do { _Pragma("unroll") for (int n = 0; n < 2; ++n) _Pragma("unroll") for (int k = 0; k < 2; ++k) dst[n][k] = *(const LAS bf16x8*)(lds + PG8_SB(b, h) + boff + n * 2048 + k * 1024); } while (0)
#define PG8_MMA(ai, bj, At, Bt) do { __builtin_amdgcn_s_setprio(1); _Pragma("unroll") for (int m = 0; m < 4; ++m) _Pragma("unroll") for (int n = 0; n < 2; ++n) _Pragma("unroll") for (int k = 0; k < 2; ++k) \
        acc[ai][bj][m][n] = __builtin_amdgcn_mfma_f32_16x16x32_f16(__builtin_bit_cast(f16x8_t, Bt[n][k]), __builtin_bit_cast(f16x8_t, At[m][k]), acc[ai][bj][m][n], 0, 0, 0); __builtin_amdgcn_s_setprio(0); } while (0)
#define PG8_WAIT_V(n) asm volatile("s_waitcnt vmcnt(" #n ")" ::: "memory")
#define PG8_WAIT_L(n) asm volatile("s_waitcnt lgkmcnt(" #n ")" ::: "memory")
#define PG8_BAR __builtin_amdgcn_s_barrier()
#define PG8_SCHED __builtin_amdgcn_sched_barrier(0)
    Unit cur, nxt; int ui = 0;
    if (!S.next(0, cur)) return;
    f32x4 acc[2][2][4][2];
#pragma unroll
    for (int a = 0; a < 2; ++a)
#pragma unroll
        for (int b = 0; b < 2; ++b)
#pragma unroll
            for (int m = 0; m < 4; ++m)
#pragma unroll
                for (int n = 0; n < 2; ++n) acc[a][b][m][n] = (f32x4){0.f, 0.f, 0.f, 0.f};
    bf16x8 At[4][2], B0[2][2], B1[2][2];
    const char* cA = (const char*)g.A + (size_t)cur.pm * tstepA; const char* cB = (const char*)g.Bt + (size_t)cur.pn * tstepB;
    PG8_STAGE(PG8_SB(0, 0), cB, voffB); PG8_STAGE(PG8_SB(0, 1), cB + hstepB, voffB); PG8_STAGE(PG8_SA(0, 0), cA, voffA); PG8_STAGE(PG8_SA(0, 1), cA + hstepA, voffA);
    if (wr == 1) PG8_BAR;
    PG8_WAIT_V(2); PG8_BAR;
    PG8_STAGE(PG8_SB(1, 0), cB + kstep, voffB); PG8_STAGE(PG8_SA(1, 0), cA + kstep, voffA); PG8_STAGE(PG8_SB(1, 1), cB + hstepB + kstep, voffB);
    PG8_WAIT_V(6); PG8_BAR;
    for (;;) {
        const bool has_next = S.next(ui + 1, nxt);
        const char* nA = has_next ? (const char*)g.A + (size_t)nxt.pm * tstepA : cA; const char* nB = has_next ? (const char*)g.Bt + (size_t)nxt.pn * tstepB : cB;
        for (int t = 0; t < nt; t += 2) {
            const bool last = (t == nt - 2);
            const char* a1 = cA + (size_t)(t + 1) * kstep;
            const char* a2 = last ? nA : cA + (size_t)(t + 2) * kstep; const char* b2 = last ? nB : cB + (size_t)(t + 2) * kstep;
            const char* a3 = a2 + kstep; const char* b3 = b2 + kstep;
            PG8_LDB(B0, 0, 0); PG8_LDB(B1, 0, 1); PG8_SCHED; PG8_LDA(At, 0, 0); PG8_STAGE(PG8_SA(1, 1), a1 + hstepA, voffA);
            PG8_WAIT_V(8); PG8_WAIT_L(0); PG8_BAR; PG8_MMA(0, 0, At, B0); PG8_MMA(0, 1, At, B1); PG8_BAR; PG8_SCHED;
            PG8_LDA(At, 0, 1); PG8_STAGE(PG8_SB(0, 0), b2, voffB); PG8_STAGE(PG8_SB(0, 1), b2 + hstepB, voffB); PG8_STAGE(PG8_SA(0, 0), a2, voffA);
            PG8_WAIT_V(8); PG8_WAIT_L(0); PG8_BAR; PG8_MMA(1, 0, At, B0); PG8_MMA(1, 1, At, B1); PG8_BAR; PG8_SCHED;
            PG8_LDB(B0, 1, 0); PG8_LDB(B1, 1, 1); PG8_SCHED; PG8_LDA(At, 1, 0); PG8_STAGE(PG8_SA(0, 1), a2 + hstepA, voffA);
            PG8_WAIT_V(8); PG8_WAIT_L(0); PG8_BAR; PG8_MMA(0, 0, At, B0); PG8_MMA(0, 1, At, B1); PG8_BAR; PG8_SCHED;
            PG8_LDA(At, 1, 1); PG8_STAGE(PG8_SB(1, 0), b3, voffB); PG8_STAGE(PG8_SB(1, 1), b3 + hstepB, voffB); PG8_STAGE(PG8_SA(1, 0), a3, voffA);
            PG8_WAIT_V(8); PG8_WAIT_L(0); PG8_BAR; PG8_MMA(1, 0, At, B0); PG8_MMA(1, 1, At, B1); PG8_BAR; PG8_SCHED;
        }
        if constexpr (ALIGN_EPI) { if (wr == 0) PG8_BAR; }
        { int fr_ = fr, fq_ = fq; asm volatile("" : "+v"(fr_), "+v"(fq_)); E(acc, cur, wr, wc, fr_, fq_); }
        if (!has_next) break;
#pragma unroll
        for (int a = 0; a < 2; ++a)
#pragma unroll
            for (int b = 0; b < 2; ++b)
#pragma unroll
                for (int m = 0; m < 4; ++m)
#pragma unroll
                    for (int n = 0; n < 2; ++n) acc[a][b][m][n] = (f32x4){0.f, 0.f, 0.f, 0.f};
        cur = nxt; cA = nA; cB = nB; ++ui;
        if constexpr (ALIGN_EPI) { if (wr == 1) PG8_BAR; }
    }
    PG8_WAIT_V(0);
    if constexpr (!ALIGN_EPI) { if (wr == 0) PG8_BAR; }
    PG8_BAR;
#undef PG8_SA
#undef PG8_SB
#undef PG8_STAGE
#undef PG8_LDA
#undef PG8_LDB
#undef PG8_MMA
#undef PG8_WAIT_V
#undef PG8_WAIT_L
#undef PG8_BAR
#undef PG8_SCHED
}
}
using pg8::cvt_pk_bf16;

__device__ __forceinline__ float shx(float v, int mask, int lane) { return __int_as_float(__builtin_amdgcn_ds_bpermute((lane ^ mask) << 2, __float_as_int(v))); }
__device__ __forceinline__ u32x4 pack8(const f32x4 a, const f32x4 b) { u32x4 w; w.x = cvt_pk_bf16(a[0], a[1]); w.y = cvt_pk_bf16(a[2], a[3]); w.z = cvt_pk_bf16(b[0], b[1]); w.w = cvt_pk_bf16(b[2], b[3]); return w; }

struct EpiNat {
    static constexpr bool PERM = true;
    bf16_t* O; int ldc; int rope_tiles; const f32x4* tabN; int swa_tiles; int kred_pn; bf16_t* KS; const f32x4* swaTab;
    __device__ __forceinline__ void operator()(const f32x4 (&acc)[2][2][4][2], const pg8::Unit& u, int wr, int wc, int fr, int fq) const {
        const int row0 = u.pm * 256 + wr * 64 + fr; const int pn = u.pn;
        if (rope_tiles && (pn < 8 || (pn >= 16 && pn < 24))) {
            const float sc = pn < 8 ? 0.0625f : 1.f;
#pragma unroll
            for (int ai = 0; ai < 2; ++ai)
#pragma unroll
                for (int m = 0; m < 4; ++m) {
                    const int r = row0 + ai * 128 + m * 16;
                    const f32x4* tp = tabN + ((size_t)r * 128 + wc * 32 + fq * 8) / 2;
                    const f32x4 t0 = tp[0], t1 = tp[1], t2 = tp[2], t3 = tp[3];
                    f32x4 o1[2], o2[2];
#pragma unroll
                    for (int n = 0; n < 2; ++n) {
                        const f32x4 ta = n ? t2 : t0, tb = n ? t3 : t1;
                        const f32x4 c = (f32x4){ta[0], ta[2], tb[0], tb[2]}, s = (f32x4){ta[1], ta[3], tb[1], tb[3]};
                        const f32x4 x1 = acc[ai][0][m][n], x2 = acc[ai][1][m][n];
                        o1[n] = (x1 * c - x2 * s) * sc; o2[n] = (x2 * c + x1 * s) * sc;
                    }
                    bf16_t* rowp = O + (size_t)r * ldc + pn * 256 + wc * 32 + 8 * fq;
                    *(u32x4*)(rowp) = pack8(o1[0], o1[1]); *(u32x4*)(rowp + 128) = pack8(o2[0], o2[1]);
                    asm volatile("" ::: "memory");
                }
        } else if ((swa_tiles && pn >= 8 && pn < 16) || pn == kred_pn) {
            bf16_t* base = O; int ld = ldc; int colt = pn * 256;
            if (pn == kred_pn) { base = KS; ld = 256; colt = 0; }
            const bool rot = (wc & 1) == 0;
#pragma unroll
            for (int ai = 0; ai < 2; ++ai)
#pragma unroll
                for (int m = 0; m < 4; ++m) {
                    const int r = row0 + ai * 128 + m * 16;
                    f32x4 v[2][2];
#pragma unroll
                    for (int bj = 0; bj < 2; ++bj)
#pragma unroll
                        for (int n = 0; n < 2; ++n) v[bj][n] = acc[ai][bj][m][n];
                    if (rot) {
                        const f32x4* tp = swaTab + (size_t)r * 4;
                        const f32x4 t0 = tp[0], t1 = tp[1], t2 = tp[2], t3 = tp[3];
#pragma unroll
                        for (int n = 0; n < 2; ++n) {
                            const f32x4 ta = n ? t2 : t0, tb = n ? t3 : t1;
                            const f32x4 c = (f32x4){ta[0], ta[2], tb[0], tb[2]}, s = (f32x4){ta[1], ta[3], tb[1], tb[3]};
#pragma unroll
                            for (int bj = 0; bj < 2; ++bj) {
                                f32x4 x = v[bj][n], px;
#pragma unroll
                                for (int i = 0; i < 4; ++i) px[i] = shx(x[i], 16, fq * 16 + fr);
                                const f32x4 lo = x * c - px * s, hi = x * c + px * s;
                                v[bj][n] = fq == 0 ? lo : (fq == 1 ? hi : x);
                            }
                        }
                    }
                    bf16_t* rowp = base + (size_t)r * ld + colt + wc * 32 + 8 * fq;
                    *(u32x4*)(rowp) = pack8(v[0][0], v[0][1]); *(u32x4*)(rowp + 128) = pack8(v[1][0], v[1][1]);
                    asm volatile("" ::: "memory");
                }
        } else {
#pragma unroll
            for (int ai = 0; ai < 2; ++ai)
#pragma unroll
                for (int m = 0; m < 4; ++m) {
                    bf16_t* rowp = O + (size_t)(row0 + ai * 128 + m * 16) * ldc + pn * 256 + wc * 32 + 8 * fq;
                    *(u32x4*)(rowp) = pack8(acc[ai][0][m][0], acc[ai][0][m][1]); *(u32x4*)(rowp + 128) = pack8(acc[ai][1][m][0], acc[ai][1][m][1]);
                }
        }
    }
};

struct EpiSwp {
    static constexpr bool PERM = true;
    bf16_t* O; int ldc; int rope_row_tiles; const float* cosT; const float* sinT;
    __device__ __forceinline__ void operator()(const f32x4 (&acc)[2][2][4][2], const pg8::Unit& u, int wr, int wc, int fr, int fq) const {
        const int row0 = u.pm * 256 + wr * 64 + fr, col0 = u.pn * 256 + wc * 32 + 8 * fq;
        if (u.pm < rope_row_tiles) {
            const float lg = logf(1.f - exp2f(-5.f - (float)u.pm));
            f32x4 zeta[2];
#pragma unroll
            for (int n = 0; n < 2; ++n)
#pragma unroll
                for (int i = 0; i < 4; ++i) zeta[n][i] = expf(lg * (float)(127 - (wc * 32 + fq * 8 + n * 4 + i))) * 0.0625f;
#pragma unroll
            for (int m = 0; m < 4; ++m) {
                const int j = wr * 64 + m * 16 + fr;
#pragma unroll
                for (int bj = 0; bj < 2; ++bj) {
                    f32x4 o1[2], o2[2];
#pragma unroll
                    for (int n = 0; n < 2; ++n) {
                        const size_t to = (size_t)j * T + col0 + bj * 128 + n * 4;
                        const f32x4 c = *(const f32x4*)(cosT + to), s = *(const f32x4*)(sinT + to);
                        const f32x4 x1 = acc[0][bj][m][n], x2 = acc[1][bj][m][n];
                        o1[n] = (x1 * c - x2 * s) * zeta[n]; o2[n] = (x2 * c + x1 * s) * zeta[n];
                    }
                    bf16_t* p1 = O + (size_t)(row0 + m * 16) * ldc + col0 + bj * 128;
                    *(u32x4*)(p1) = pack8(o1[0], o1[1]); *(u32x4*)(p1 + (size_t)128 * ldc) = pack8(o2[0], o2[1]);
                    asm volatile("" ::: "memory");
                }
            }
        } else {
#pragma unroll
            for (int ai = 0; ai < 2; ++ai)
#pragma unroll
                for (int m = 0; m < 4; ++m) {
                    bf16_t* rowp = O + (size_t)(row0 + ai * 128 + m * 16) * ldc + col0;
                    *(u32x4*)(rowp) = pack8(acc[ai][0][m][0], acc[ai][0][m][1]); *(u32x4*)(rowp + 128) = pack8(acc[ai][1][m][0], acc[ai][1][m][1]);
                }
        }
    }
};

struct EpiF32 {
    static constexpr bool PERM = false;
    float* C; int ldc;
    __device__ __forceinline__ void operator()(const f32x4 (&acc)[2][2][4][2], const pg8::Unit& u, int wr, int wc, int fr, int fq) const {
        const int row0 = u.pm * 256 + wr * 64 + fr, col0 = u.pn * 256 + wc * 32 + 4 * fq;
#pragma unroll
        for (int ai = 0; ai < 2; ++ai)
#pragma unroll
            for (int m = 0; m < 4; ++m) { float* rowp = C + (size_t)(row0 + ai * 128 + m * 16) * ldc + col0;
#pragma unroll
                for (int bj = 0; bj < 2; ++bj)
#pragma unroll
                    for (int n = 0; n < 2; ++n) *(f32x4*)(rowp + bj * 128 + n * 16) = acc[ai][bj][m][n]; }
    }
};

__device__ __forceinline__ float wave_sum(float v, int lane) {
#pragma unroll
    for (int o = 1; o < 64; o <<= 1) v += shx(v, o, lane);
    return v;
}
__device__ __forceinline__ float bf2f(unsigned short b) { return (float)__builtin_bit_cast(_Float16, b); }
__device__ __forceinline__ float bflo(unsigned w) { return (float)__builtin_bit_cast(_Float16, (unsigned short)(w & 0xffffu)); }
__device__ __forceinline__ float bfhi(unsigned w) { return (float)__builtin_bit_cast(_Float16, (unsigned short)(w >> 16)); }
__device__ __forceinline__ unsigned short f2bf(float f) { return (unsigned short)(cvt_pk_bf16(f, 0.f) & 0xffffu); }
__device__ __forceinline__ f32x4 mfma16(bf16x8 a, bf16x8 b, f32x4 c) { return __builtin_amdgcn_mfma_f32_16x16x32_f16(__builtin_bit_cast(pg8::f16x8_t, a), __builtin_bit_cast(pg8::f16x8_t, b), c, 0, 0, 0); }
__device__ __forceinline__ bf16x8 ldg8(const bf16_t* p) { return *(const bf16x8*)p; }
__device__ __forceinline__ bf16x8 lds8(const LAS unsigned char* p) { return *(const LAS bf16x8*)p; }
__device__ __forceinline__ float silu(float g) { return g / (1.f + __expf(-g)); }
#define LDS_WAIT() asm volatile("s_waitcnt lgkmcnt(0)" ::: "memory")

template <int ROWS, int ROWB, int LP>
__device__ __forceinline__ void stage_tile(LAS unsigned char* dst, const unsigned char* src, size_t gpitch, int tid) {
    constexpr int CPR = ROWB / 16, TOTAL = ROWS * CPR, ITER = TOTAL / NTHREADS;
    static_assert(TOTAL % NTHREADS == 0, "stage_tile");
    constexpr int BATCH = ITER < 8 ? ITER : 8;
    static_assert(ITER % BATCH == 0, "stage_tile batch");
#pragma unroll
    for (int k0 = 0; k0 < ITER; k0 += BATCH) {
        u32x4 v[BATCH];
#pragma unroll
        for (int k = 0; k < BATCH; ++k) { const int c = tid + (k0 + k) * NTHREADS, r = c / CPR, cc = c % CPR; v[k] = *(const u32x4*)(src + (size_t)r * gpitch + cc * 16); }
#pragma unroll
        for (int k = 0; k < BATCH; ++k) { const int c = tid + (k0 + k) * NTHREADS, r = c / CPR, cc = c % CPR; *(LAS u32x4*)(dst + r * LP + cc * 16) = v[k]; }
        asm volatile("" ::: "memory");
    }
}

__device__ __forceinline__ u32x4 gate8(u32x4 o, u32x4 g) {
    u32x4 r;
#pragma unroll
    for (int k = 0; k < 4; ++k) r[k] = cvt_pk_bf16(bflo(o[k]) * silu(bflo(g[k])), bfhi(o[k]) * silu(bfhi(g[k])));
    return r;
}

__device__ __forceinline__ void sincos_f(float ang, float& c, float& s) {
    const double a = (double)ang, k = rint(a * 0.63661977236758134308);
    double r = fma(-k, 1.57079632679489661923, a); r = fma(-k, 6.123233995736766e-17, r);
    const double r2 = r * r;
    const double sn = r * (1.0 + r2 * (-1.0 / 6 + r2 * (1.0 / 120 + r2 * (-1.0 / 5040 + r2 * (1.0 / 362880 + r2 * (-1.0 / 39916800))))));
    const double cs = 1.0 + r2 * (-0.5 + r2 * (1.0 / 24 + r2 * (-1.0 / 720 + r2 * (1.0 / 40320 + r2 * (-1.0 / 3628800 + r2 * (1.0 / 479001600))))));
    const int q = ((int)k) & 3;
    const float fs = (float)sn, fc = (float)cs;
    c = (q == 0) ? fc : (q == 1) ? -fs : (q == 2) ? -fc : fs;
    s = (q == 0) ? fs : (q == 1) ? fc : (q == 2) ? -fs : -fc;
}

__device__ __forceinline__ void convert_block(const float* W, int ldw, int col0, int ncols, int K, const float* gain, bf16_t* WT, LAS float* scr, int gw, int NGW, int lane) {
    const int nblk = ncols / 32, items = (K / 64) * nblk;
    for (int it = gw; it < items; it += NGW) {
        const int kb = it / nblk, nb = it % nblk, k0 = 64 * kb, n0 = 32 * nb;
        const int c = lane & 7;
        f32x4 g0 = (f32x4){1.f, 1.f, 1.f, 1.f}, g1 = g0;
        if (gain) { g0 = *(const f32x4*)(gain + k0 + 8 * c); g1 = *(const f32x4*)(gain + k0 + 8 * c + 4); }
        const float* wp = W + (size_t)(k0 + (lane >> 5)) * ldw + col0 + n0 + (lane & 31);
        float v[32];
#pragma unroll
        for (int i = 0; i < 32; ++i) v[i] = wp[(size_t)(2 * i) * ldw];
#pragma unroll
        for (int i = 0; i < 32; ++i) scr[(2 * i + (lane >> 5)) * 33 + (lane & 31)] = v[i];
        LDS_WAIT();
#pragma unroll
        for (int j = 0; j < 4; ++j) { const int n = (lane >> 3) + 8 * j; const LAS float* s = scr + (8 * c) * 33 + n;
            u32x4 o; o.x = cvt_pk_bf16(s[0 * 33] * g0[0], s[1 * 33] * g0[1]); o.y = cvt_pk_bf16(s[2 * 33] * g0[2], s[3 * 33] * g0[3]);
            o.z = cvt_pk_bf16(s[4 * 33] * g1[0], s[5 * 33] * g1[1]); o.w = cvt_pk_bf16(s[6 * 33] * g1[2], s[7 * 33] * g1[3]);
            *(u32x4*)(WT + (size_t)(n0 + n) * K + k0 + 8 * c) = o; }
        LDS_WAIT();
    }
}

__device__ __forceinline__ void convert_layer(const Params& p, int l, LAS float* scr, int gw, int NGW, int lane) {
    int wz_ = 0; asm volatile("" : "+s"(wz_)); unsigned char* ws = p.ws + wz_;
    bf16_t* WNAT = (bf16_t*)(ws + WS_WNAT); bf16_t* WSWP = (bf16_t*)(ws + WS_WSWP); bf16_t* WOUT = (bf16_t*)(ws + WS_WOUT);
    const float* pg = p.pre_g + (size_t)l * D;
    if (l < 2) {
        const float* W = p.w_in_a + (size_t)l * D * 10240;
        convert_block(W, 10240, 2048, 2048, D, pg, WNAT, scr, gw, NGW, lane);
        convert_block(W, 10240, 6144, 2048, D, pg, WNAT + (size_t)2048 * D, scr, gw, NGW, lane);
        convert_block(W, 10240, 0, 2048, D, pg, WNAT + (size_t)4096 * D, scr, gw, NGW, lane);
        convert_block(W, 10240, 8192, 2048, D, pg, WNAT + (size_t)6144 * D, scr, gw, NGW, lane);
        convert_block(W, 10240, 4096, 2048, D, pg, WSWP + (size_t)2048 * D, scr, gw, NGW, lane);
    } else {
        const float* W = p.w_in_b + (size_t)(l - 2) * D * 6144;
        convert_block(W, 6144, 2048, 2048, D, pg, WNAT, scr, gw, NGW, lane);
        convert_block(W, 6144, 0, 2048, D, pg, WNAT + (size_t)2048 * D, scr, gw, NGW, lane);
        convert_block(W, 6144, 4096, 2048, D, pg, WNAT + (size_t)4096 * D, scr, gw, NGW, lane);
        if (l == 2) {
            convert_block(p.w_kv_b, 512, 0, 256, D, p.kv_g, WNAT + (size_t)6144 * D, scr, gw, NGW, lane);
            convert_block(p.w_kv_b, 512, 256, 256, D, p.kv_g, WSWP, scr, gw, NGW, lane);
        }
    }
    convert_block(p.w_out + (size_t)l * 3072 * D, D, 0, D, 3072, nullptr, WOUT, scr, gw, NGW, lane);
}

__device__ __forceinline__ void norm_row_bf16(const float* xrow, bf16_t* orow, int lane) {
    const f32x4* xr = (const f32x4*)xrow + lane;
    f32x4 v[8]; float s = 0.f;
#pragma unroll
    for (int j = 0; j < 8; ++j) { v[j] = xr[64 * j]; s += (v[j][0] * v[j][0] + v[j][1] * v[j][1]) + (v[j][2] * v[j][2] + v[j][3] * v[j][3]); }
    const float rs = rsqrtf(wave_sum(s, lane) * (1.f / D) + EPS);
    u32x2* o8 = (u32x2*)orow + lane;
#pragma unroll
    for (int j = 0; j < 8; ++j) { u32x2 w; w.x = cvt_pk_bf16(v[j][0] * rs, v[j][1] * rs); w.y = cvt_pk_bf16(v[j][2] * rs, v[j][3] * rs); o8[64 * j] = w; }
}

__device__ __forceinline__ void norm_row2_bf16(const float* xrow, bf16_t* orow, size_t stride, int lane) {
    f32x4 v[2][8]; float s[2] = {0.f, 0.f};
#pragma unroll
    for (int r = 0; r < 2; ++r) { const f32x4* xr = (const f32x4*)(xrow + r * stride) + lane;
#pragma unroll
        for (int j = 0; j < 8; ++j) v[r][j] = xr[64 * j]; }
#pragma unroll
    for (int r = 0; r < 2; ++r) {
#pragma unroll
        for (int j = 0; j < 8; ++j) s[r] += (v[r][j][0] * v[r][j][0] + v[r][j][1] * v[r][j][1]) + (v[r][j][2] * v[r][j][2] + v[r][j][3] * v[r][j][3]);
        const float rs = rsqrtf(wave_sum(s[r], lane) * (1.f / D) + EPS);
        u32x2* o8 = (u32x2*)(orow + r * stride) + lane;
#pragma unroll
        for (int j = 0; j < 8; ++j) { u32x2 w; w.x = cvt_pk_bf16(v[r][j][0] * rs, v[r][j][1] * rs); w.y = cvt_pk_bf16(v[r][j][2] * rs, v[r][j][3] * rs); o8[64 * j] = w; }
    }
}
__device__ __forceinline__ void phase_p0(const Params& p, LAS unsigned char* lds, int tid, int wave, int lane) {
    asm volatile("" : "+v"(lane), "+v"(tid));
    int wz_ = 0; asm volatile("" : "+s"(wz_)); unsigned char* ws = p.ws + wz_;
    const int G = gridDim.x, gw = blockIdx.x * NWAVES + wave, NGW = G * NWAVES;
    const size_t gt = (size_t)blockIdx.x * NTHREADS + tid, NT = (size_t)G * NTHREADS;
    f32x2* tabN = (f32x2*)(ws + WS_TABN); f32x2* swat = (f32x2*)(ws + WS_SWAT);
    for (size_t i = gt; i < (size_t)T * 128; i += NT) { const int tok = (int)(i >> 7), j = (int)(i & 127); float c, s; sincos_f((float)p.pos[tok] * p.inv_ret[j], c, s); tabN[i] = (f32x2){c, s}; }
    for (size_t i = gt; i < (size_t)T * 8; i += NT) { const int tok = (int)(i >> 3), j = (int)(i & 7); float c, s; sincos_f((float)p.pos[tok] * p.inv_swa[j], c, s); swat[i] = (f32x2){c, s}; }
    for (int m = gw; m < 1024; m += NGW) norm_row_bf16(p.mem + (size_t)m * D, (bf16_t*)(ws + WS_MEMN) + (size_t)m * D, lane);
    for (int m = gw; m < T; m += 2 * NGW) norm_row2_bf16(p.x + (size_t)m * D, (bf16_t*)(ws + WS_YN) + (size_t)m * D, (size_t)NGW * D, lane);
    LAS float* scr = (LAS float*)(lds + wave * 16384);
    for (int l = 0; l < 4; ++l) {
        convert_block(p.w_mem_kv + (size_t)l * D * 2048, 2048, 0, 1024, D, p.mem_g + (size_t)l * D, (bf16_t*)(ws + WS_WMK) + (size_t)l * 1024 * D, scr, gw, NGW, lane);
        convert_block(p.w_mem_kv + (size_t)l * D * 2048, 2048, 1024, 1024, D, p.mem_g + (size_t)l * D, (bf16_t*)(ws + WS_WMV) + (size_t)l * 1024 * D, scr, gw, NGW, lane);
    }
    convert_layer(p, 0, scr, gw, NGW, lane);
}

__device__ __forceinline__ void phase_norm(const Params& p, int l, LAS unsigned char* lds, int wave, int lane) {
    asm volatile("" : "+v"(lane));
    int wz_ = 0; asm volatile("" : "+s"(wz_)); unsigned char* ws = p.ws + wz_;
    const int gw = blockIdx.x * NWAVES + wave, NGW = gridDim.x * NWAVES;
    const bf16_t* OUTH = (const bf16_t*)(ws + WS_OUTF); bf16_t* YN = (bf16_t*)(ws + WS_YN);
    const float* hin = ((l == 0) ? p.x : p.out) + wz_; float* hout = p.out + wz_;
    f32x4 pg[8];
#pragma unroll
    for (int j = 0; j < 8; ++j) pg[j] = *((const f32x4*)(p.post_g + wz_ + (size_t)l * D) + lane + 64 * j);
    for (int m0 = gw; m0 < T; m0 += 2 * NGW) {
        f32x4 o[2][8], h[2][8];
#pragma unroll
        for (int r = 0; r < 2; ++r) { const int m = m0 + r * NGW;
            const u32x2* orow = (const u32x2*)(OUTH + (size_t)m * D) + lane; const f32x4* hrow = (const f32x4*)(hin + (size_t)m * D) + lane;
#pragma unroll
            for (int j = 0; j < 8; ++j) { const u32x2 ow = orow[64 * j]; o[r][j] = (f32x4){bflo(ow.x), bfhi(ow.x), bflo(ow.y), bfhi(ow.y)}; h[r][j] = hrow[64 * j]; } }
#pragma unroll
        for (int r = 0; r < 2; ++r) { const int m = m0 + r * NGW;
            float s = 0.f;
#pragma unroll
            for (int j = 0; j < 8; ++j) s += (o[r][j][0] * o[r][j][0] + o[r][j][1] * o[r][j][1]) + (o[r][j][2] * o[r][j][2] + o[r][j][3] * o[r][j][3]);
            const float rs = rsqrtf(wave_sum(s, lane) * (1.f / D) + EPS);
            float s2 = 0.f;
#pragma unroll
            for (int j = 0; j < 8; ++j) { h[r][j] = h[r][j] + o[r][j] * rs * pg[j]; s2 += (h[r][j][0] * h[r][j][0] + h[r][j][1] * h[r][j][1]) + (h[r][j][2] * h[r][j][2] + h[r][j][3] * h[r][j][3]); }
            f32x4* drow = (f32x4*)(hout + (size_t)m * D) + lane;
#pragma unroll
            for (int j = 0; j < 8; ++j) drow[64 * j] = h[r][j];
            if (l < 3) {
                const float rs2 = rsqrtf(wave_sum(s2, lane) * (1.f / D) + EPS);
                u32x2* o8 = (u32x2*)(YN + (size_t)m * D) + lane;
#pragma unroll
                for (int j = 0; j < 8; ++j) { u32x2 w; w.x = cvt_pk_bf16(h[r][j][0] * rs2, h[r][j][1] * rs2); w.y = cvt_pk_bf16(h[r][j][2] * rs2, h[r][j][3] * rs2); o8[64 * j] = w; }
            }
        }
    }
    if (l < 3) convert_layer(p, l + 1, (LAS float*)(lds + wave * 16384), gw, NGW, lane);
}

typedef short v4i16_t __attribute__((ext_vector_type(4)));
__device__ __forceinline__ unsigned mulh2(unsigned a, pg8::f16x2_t z) { const pg8::f16x2_t r = __builtin_bit_cast(pg8::f16x2_t, a) * z; return __builtin_bit_cast(unsigned, r); }
__device__ __forceinline__ v4i16_t lds_tr(const LAS unsigned char* p) { return __builtin_amdgcn_ds_read_tr16_b64_v4i16((LAS v4i16_t*)p); }
__device__ __forceinline__ void scan_unit(const bf16_t* Zk, const bf16_t* KVT, bf16_t* RT, LAS unsigned char* lds, int u, int wave, int lane) {
    asm volatile("" : "+v"(lane));
    const int tid = wave * 64 + lane;
    const int b = u >> 6, h = (u >> 3) & 7, sl = u & 7, fr = lane & 15, fq = lane >> 4;
    const int dk0 = wave * 32, dv0 = sl * 32;
    const float lg = logf(1.f - exp2f(-5.f - (float)h));
    const float gch = expf(lg * 128.f);
    constexpr int KP = 528, KB = 128 * KP;
    const int krow = tid >> 5, kcc = tid & 31;
    const bf16_t* kbase = Zk + (size_t)(b * SEQ + krow) * 8192 + h * 256 + kcc * 8;
    const bf16_t* vbase = KVT + (size_t)(2048 + h * 256 + dv0 + (tid >> 4)) * T + b * SEQ + (tid & 15) * 8;
    LAS unsigned char* Vl = lds + 2 * KB;
    const int vst = (tid >> 4) * 272 + (tid & 15) * 16, vrd = fr * 272 + fq * 16;
    bf16_t* rbase = RT + (size_t)((b * 8 + h) * 32) * 65536 + (size_t)(dv0 + fr) * 256 + dk0 + 4 * fq;
    const int kst = krow * KP + kcc * 16;
    const int ktr = (8 * fq + (fr >> 2)) * KP + dk0 * 2 + (fr & 3) * 8;
    pg8::f16x2_t zz[8];
#pragma unroll
    for (int k = 0; k < 8; ++k) { const _Float16 z = (_Float16)expf(lg * (float)(127 - (krow + 16 * k))); zz[k] = (pg8::f16x2_t){z, z}; }
    f32x4 acc[2][2];
#pragma unroll
    for (int a = 0; a < 2; ++a)
#pragma unroll
        for (int c = 0; c < 2; ++c) acc[a][c] = (f32x4){0.f, 0.f, 0.f, 0.f};
    u32x4 kr[8]; u32x4 vr;
#define SC_LOADK(n_) do { _Pragma("unroll") for (int k_ = 0; k_ < 8; ++k_) kr[k_] = *(const u32x4*)(kbase + (size_t)((n_) * 128 + 16 * k_) * 8192); } while (0)
#define SC_PUTK(buf_) do { _Pragma("unroll") for (int k_ = 0; k_ < 8; ++k_) { const u32x4 s_ = kr[k_]; u32x4 t_; t_.x = mulh2(s_.x, zz[k_]); t_.y = mulh2(s_.y, zz[k_]); t_.z = mulh2(s_.z, zz[k_]); t_.w = mulh2(s_.w, zz[k_]); \
        *(LAS u32x4*)(lds + (buf_) * KB + kst + k_ * 16 * KP) = t_; } } while (0)
#define SC_LOADV(n_) do { vr = *(const u32x4*)(vbase + (n_) * 128); } while (0)
#define SC_PUTV() do { *(LAS u32x4*)(Vl + vst) = vr; } while (0)
#define SC_STORE(n_) do { _Pragma("unroll") for (int mt_ = 0; mt_ < 2; ++mt_) _Pragma("unroll") for (int nt_ = 0; nt_ < 2; ++nt_) { u32x2 w_; \
        w_.x = cvt_pk_bf16(acc[mt_][nt_][0], acc[mt_][nt_][1]); w_.y = cvt_pk_bf16(acc[mt_][nt_][2], acc[mt_][nt_][3]); \
        *(u32x2*)(rbase + (size_t)(n_) * 65536 + nt_ * 16 * 256 + mt_ * 16) = w_; } } while (0)
#define SC_COMP(buf_) do { \
        _Pragma("unroll") for (int mt_ = 0; mt_ < 2; ++mt_) { bf16x8 A_[4]; \
            _Pragma("unroll") for (int k_ = 0; k_ < 4; ++k_) { \
                const v4i16_t lo_ = lds_tr(lds + (buf_) * KB + ktr + (k_ * 32) * KP + mt_ * 32), hi_ = lds_tr(lds + (buf_) * KB + ktr + (k_ * 32 + 4) * KP + mt_ * 32); \
                A_[k_] = (bf16x8){lo_.x, lo_.y, lo_.z, lo_.w, hi_.x, hi_.y, hi_.z, hi_.w}; } \
            _Pragma("unroll") for (int nt_ = 0; nt_ < 2; ++nt_) { acc[mt_][nt_] = acc[mt_][nt_] * gch; \
                _Pragma("unroll") for (int k_ = 0; k_ < 4; ++k_) acc[mt_][nt_] = mfma16(A_[k_], lds8(Vl + vrd + nt_ * 16 * 272 + k_ * 64), acc[mt_][nt_]); } } \
        } while (0)
    SC_LOADK(0); SC_LOADV(0);
    SC_PUTK(0); SC_PUTV();
    SC_LOADK(1);
    __syncthreads();
#define SC_STEP(n_, cur_, nxt_, LOADK_) do { SC_STORE(n_); SC_LOADV((n_) + 1); SC_COMP(cur_); __syncthreads();     \
        SC_PUTK(nxt_); SC_PUTV(); LOADK_; __syncthreads(); } while (0)
    for (int n = 0; n < 30; n += 2) {
        SC_STEP(n, 0, 1, SC_LOADK(n + 2));
        SC_STEP(n + 1, 1, 0, if (n + 3 <= 30) SC_LOADK(n + 3));
    }
    SC_STORE(30); SC_COMP(0);
    SC_STORE(31);
    __syncthreads();
#undef SC_STEP
#undef SC_LOADV
#undef SC_PUTV
#undef SC_LOADK
#undef SC_PUTK
#undef SC_STORE
#undef SC_COMP
}

__device__ __forceinline__ void retc_unit(const Params& p, int u, LAS unsigned char* lds, int tid, int wave, int lane) {
    asm volatile("" : "+v"(lane), "+v"(tid));
    int wz_ = 0; asm volatile("" : "+s"(wz_)); unsigned char* ws = p.ws + wz_;
    bf16_t* Z = (bf16_t*)(ws + WS_Z); const bf16_t* KVT = (const bf16_t*)(ws + WS_KVT); const bf16_t* RT = (const bf16_t*)(ws + WS_RT);
    const int b = u >> 8, h = (u >> 5) & 7, n = u & 31, fr = lane & 15, fq = lane >> 4;
    const int tok0 = b * SEQ + n * 128, q0 = wave * 16;
    const float lg = logf(1.f - exp2f(-5.f - (float)h));
    LAS unsigned char* X = lds; LAS unsigned char* Y = lds + REG_B;
    bf16x8 qf[8];
#pragma unroll
    for (int ks = 0; ks < 8; ++ks) qf[ks] = ldg8(Z + (size_t)(tok0 + q0 + fr) * 8192 + 4096 + h * 256 + ks * 32 + fq * 8);
    const unsigned char* rt = (const unsigned char*)(RT + (size_t)((b * 8 + h) * 32 + n) * 65536);
    __syncthreads();
    stage_tile<128, 512, 544>(X, rt, 512, tid);
    stage_tile<128, 512, 544>(Y, rt + 128 * 512, 512, tid);
    __syncthreads();
    f32x4 acc[16];
#pragma unroll
    for (int nt = 0; nt < 16; ++nt) acc[nt] = (f32x4){0.f, 0.f, 0.f, 0.f};
#pragma unroll
    for (int nt = 0; nt < 16; ++nt) {
        const LAS unsigned char* rp = (nt < 8 ? X : Y) + ((nt & 7) * 16 + fr) * 544 + fq * 16;
#pragma unroll
        for (int ks = 0; ks < 8; ++ks) acc[nt] = mfma16(qf[ks], lds8(rp + ks * 64), acc[nt]);
    }
    {
        f32x4 xi;
#pragma unroll
        for (int i = 0; i < 4; ++i) xi[i] = expf(lg * (float)(q0 + 4 * fq + i + 1));
#pragma unroll
        for (int nt = 0; nt < 16; ++nt) acc[nt] = acc[nt] * xi;
    }
    __syncthreads();
    stage_tile<128, 512, 544>(X, (const unsigned char*)(Z + (size_t)tok0 * 8192 + h * 256), 8192 * 2, tid);
    stage_tile<256, 256, 288>(Y, (const unsigned char*)(KVT + (size_t)(2048 + h * 256) * T + tok0), (size_t)T * 2, tid);
    __syncthreads();
    f32x4 s[8];
#pragma unroll
    for (int nt = 0; nt < 8; ++nt) {
        s[nt] = (f32x4){0.f, 0.f, 0.f, 0.f};
        const LAS unsigned char* kp = X + (nt * 16 + fr) * 544 + fq * 16;
#pragma unroll
        for (int ks = 0; ks < 8; ++ks) s[nt] = mfma16(lds8(kp + ks * 64), qf[ks], s[nt]);
    }
    __syncthreads();
    LAS unsigned char* Pw = X + wave * 9216;
    {
        const float lg2 = lg * 1.4426950408889634f; const int qpos = q0 + fr;
#pragma unroll
        for (int nt = 0; nt < 8; ++nt) {
            f32x4 v;
#pragma unroll
            for (int i = 0; i < 4; ++i) { const int d = qpos - (nt * 16 + 4 * fq + i); v[i] = d >= 0 ? s[nt][i] * exp2f(lg2 * (float)d) : 0.f; }
            u32x2 w; w.x = cvt_pk_bf16(v[0], v[1]); w.y = cvt_pk_bf16(v[2], v[3]);
            *(LAS u32x2*)(Pw + fr * 288 + (nt * 16 + 4 * fq) * 2) = w;
        }
    }
    LDS_WAIT();
#pragma unroll
    for (int ks = 0; ks < 4; ++ks) {
        const bf16x8 pf = lds8(Pw + fr * 288 + ks * 64 + fq * 16);
#pragma unroll
        for (int nt = 0; nt < 16; ++nt) acc[nt] = mfma16(pf, lds8(Y + (nt * 16 + fr) * 288 + ks * 64 + fq * 16), acc[nt]);
    }
    u32x4 gvr[8];
#pragma unroll
    for (int k = 0; k < 8; ++k) { const int c = lane + 64 * k, row = c >> 5, cc = c & 31;
        gvr[k] = *(const u32x4*)(Z + (size_t)(tok0 + q0 + row) * 8192 + h * 256 + cc * 8 + 2048); }
    f32x4 ss = (f32x4){0.f, 0.f, 0.f, 0.f};
#pragma unroll
    for (int nt = 0; nt < 16; ++nt) ss = ss + acc[nt] * acc[nt];
#pragma unroll
    for (int o = 1; o < 16; o <<= 1)
#pragma unroll
        for (int i = 0; i < 4; ++i) ss[i] += shx(ss[i], o, lane);
    f32x4 rs;
#pragma unroll
    for (int i = 0; i < 4; ++i) rs[i] = rsqrtf(ss[i] * (1.f / 256.f) + EPS);
    LDS_WAIT();
#pragma unroll
    for (int nt = 0; nt < 16; ++nt)
#pragma unroll
        for (int i = 0; i < 4; ++i) *(LAS unsigned short*)(Pw + (4 * fq + i) * 544 + (nt * 16 + fr) * 2) = f2bf(acc[nt][i] * rs[i]);
    LDS_WAIT();
#pragma unroll
    for (int k = 0; k < 8; ++k) {
        const int c = lane + 64 * k, row = c >> 5, cc = c & 31;
        const u32x4 ov = *(const LAS u32x4*)(Pw + row * 544 + cc * 16);
        const size_t ro = (size_t)(tok0 + q0 + row) * 8192 + h * 256 + cc * 8;
        *(u32x4*)(Z + ro + 4096) = gate8(ov, gvr[k]);
    }
}

__device__ __forceinline__ void memattn_unit(const Params& p, int l, int u, int zld, int qcol0, LAS unsigned char* lds, int tid, int wave, int lane) {
    asm volatile("" : "+v"(lane), "+v"(tid));
    int wz_ = 0; asm volatile("" : "+s"(wz_)); unsigned char* ws = p.ws + wz_;
    bf16_t* Z = (bf16_t*)(ws + WS_Z); const bf16_t* MK = (const bf16_t*)(ws + WS_MK); const bf16_t* MVT = (const bf16_t*)(ws + WS_MVT);
    const int b = u >> 7, hm = (u >> 5) & 3, qb = u & 31, fr = lane & 15, fq = lane >> 4;
    const int tok0 = b * SEQ + qb * 128, q0 = wave * 16, qcol = qcol0 + hm * 256, gcol = qcol + 1024;
    LAS unsigned char* X = lds; LAS unsigned char* Y = lds + REG_B;
    bf16x8 qf[8];
#pragma unroll
    for (int ks = 0; ks < 8; ++ks) qf[ks] = ldg8(Z + (size_t)(tok0 + q0 + fr) * zld + qcol + ks * 32 + fq * 8);
    const unsigned char* mk = (const unsigned char*)(MK + (size_t)(b * 256) * 4096 + l * 1024 + hm * 256);
    const unsigned char* mv = (const unsigned char*)(MVT + (size_t)(l * 1024 + hm * 256) * 1024 + b * 256);
    __syncthreads();
    stage_tile<128, 512, 544>(X, mk, 4096 * 2, tid);
    stage_tile<128, 512, 544>(Y, mk + (size_t)128 * 4096 * 2, 4096 * 2, tid);
    __syncthreads();
    f32x4 s[16];
#pragma unroll
    for (int nt = 0; nt < 16; ++nt) {
        s[nt] = (f32x4){0.f, 0.f, 0.f, 0.f};
        const LAS unsigned char* kp = (nt < 8 ? X : Y) + ((nt & 7) * 16 + fr) * 544 + fq * 16;
#pragma unroll
        for (int ks = 0; ks < 8; ++ks) s[nt] = mfma16(lds8(kp + ks * 64), qf[ks], s[nt]);
    }
    float mx = -3.0e38f;
#pragma unroll
    for (int nt = 0; nt < 16; ++nt)
#pragma unroll
        for (int i = 0; i < 4; ++i) mx = fmaxf(mx, s[nt][i]);
    mx = fmaxf(mx, shx(mx, 16, lane)); mx = fmaxf(mx, shx(mx, 32, lane));
    float sum = 0.f;
#pragma unroll
    for (int nt = 0; nt < 16; ++nt)
#pragma unroll
        for (int i = 0; i < 4; ++i) { s[nt][i] = __expf((s[nt][i] - mx) * 0.0625f); sum += s[nt][i]; }
    sum += shx(sum, 16, lane); sum += shx(sum, 32, lane);
    const float inv = 1.f / sum;
    __syncthreads();
    LAS unsigned char* Pw = Y + wave * 9216;
#pragma unroll
    for (int nt = 0; nt < 16; ++nt) { u32x2 w; w.x = cvt_pk_bf16(s[nt][0] * inv, s[nt][1] * inv); w.y = cvt_pk_bf16(s[nt][2] * inv, s[nt][3] * inv);
        *(LAS u32x2*)(Pw + fr * 544 + (nt * 16 + 4 * fq) * 2) = w; }
    stage_tile<128, 512, 544>(X, mv, 1024 * 2, tid);
    __syncthreads();
    f32x4 acc[16];
#pragma unroll
    for (int nt = 0; nt < 16; ++nt) acc[nt] = (f32x4){0.f, 0.f, 0.f, 0.f};
#pragma unroll
    for (int ks = 0; ks < 8; ++ks) {
        const bf16x8 pf = lds8(Pw + fr * 544 + ks * 64 + fq * 16);
#pragma unroll
        for (int nt = 0; nt < 8; ++nt) acc[nt] = mfma16(pf, lds8(X + (nt * 16 + fr) * 544 + ks * 64 + fq * 16), acc[nt]);
    }
    __syncthreads();
    stage_tile<128, 512, 544>(X, mv + (size_t)128 * 1024 * 2, 1024 * 2, tid);
    __syncthreads();
#pragma unroll
    for (int ks = 0; ks < 8; ++ks) {
        const bf16x8 pf = lds8(Pw + fr * 544 + ks * 64 + fq * 16);
#pragma unroll
        for (int nt = 0; nt < 8; ++nt) acc[8 + nt] = mfma16(pf, lds8(X + (nt * 16 + fr) * 544 + ks * 64 + fq * 16), acc[8 + nt]);
    }
    u32x4 gvm[8];
#pragma unroll
    for (int k = 0; k < 8; ++k) { const int c = lane + 64 * k, row = c >> 5, cc = c & 31;
        gvm[k] = *(const u32x4*)(Z + (size_t)(tok0 + q0 + row) * zld + gcol + cc * 8); }
    LDS_WAIT();
#pragma unroll
    for (int nt = 0; nt < 16; ++nt)
#pragma unroll
        for (int i = 0; i < 4; ++i) *(LAS unsigned short*)(Pw + (4 * fq + i) * 544 + (nt * 16 + fr) * 2) = f2bf(acc[nt][i]);
    LDS_WAIT();
#pragma unroll
    for (int k = 0; k < 8; ++k) {
        const int c = lane + 64 * k, row = c >> 5, cc = c & 31;
        const u32x4 ov = *(const LAS u32x4*)(Pw + row * 544 + cc * 16);
        const size_t ro = (size_t)(tok0 + q0 + row) * zld;
        *(u32x4*)(Z + ro + qcol + cc * 8) = gate8(ov, gvm[k]);
    }
}

__device__ __forceinline__ void swa_unit(const Params& p, int lb, int u, LAS unsigned char* lds, int tid, int wave, int lane) {
    asm volatile("" : "+v"(lane), "+v"(tid));
    int wz_ = 0; asm volatile("" : "+s"(wz_)); unsigned char* ws = p.ws + wz_;
    bf16_t* Z = (bf16_t*)(ws + WS_Z); const bf16_t* KS = (const bf16_t*)(ws + WS_KS); const bf16_t* VST = (const bf16_t*)(ws + WS_VST);
    const int b = u >> 7, kvh = (u >> 5) & 3, n = u & 31, fr = lane & 15, fq = lane >> 4;
    const int tok0 = b * SEQ + n * 128, hq = kvh * 8 + wave;
    const float sink = p.sinks[lb * 32 + hq];
    LAS unsigned char* X = lds; LAS unsigned char* Y = lds + 40960; LAS unsigned char* Pw = lds + 75776 + wave * 8704;
    __syncthreads();
    {
#pragma unroll
        for (int k = 0; k < 4; ++k) { const int c = tid + k * NTHREADS, r = c >> 3, cc = c & 7; u32x4 v = (u32x4){0u, 0u, 0u, 0u};
            if (n > 0 || r >= 128) v = *(const u32x4*)(KS + (size_t)(tok0 - 128 + r) * 256 + kvh * 64 + cc * 8);
            *(LAS u32x4*)(X + r * 160 + cc * 16) = v; }
#pragma unroll
        for (int k = 0; k < 4; ++k) { const int c = tid + k * NTHREADS, r = c >> 5, cc = c & 31; u32x4 v = (u32x4){0u, 0u, 0u, 0u};
            if (n > 0 || cc >= 16) v = *(const u32x4*)(VST + (size_t)(kvh * 64 + r) * T + tok0 - 128 + cc * 8);
            *(LAS u32x4*)(Y + r * 544 + cc * 16) = v; }
    }
    __syncthreads();
    for (int mt = 0; mt < 8; ++mt) {
        bf16x8 qf[2];
#pragma unroll
        for (int ks = 0; ks < 2; ++ks) qf[ks] = ldg8(Z + (size_t)(tok0 + mt * 16 + fr) * 6144 + 2048 + hq * 64 + ks * 32 + fq * 8);
        u32x4 gvs[2];
#pragma unroll
        for (int k = 0; k < 2; ++k) { const int c = lane + 64 * k, row = c >> 3, cc = c & 7; gvs[k] = *(const u32x4*)(Z + (size_t)(tok0 + mt * 16 + row) * 6144 + hq * 64 + cc * 8); }
        f32x4 s[16];
#pragma unroll
        for (int nt = 0; nt < 16; ++nt) {
            s[nt] = (f32x4){0.f, 0.f, 0.f, 0.f};
#pragma unroll
            for (int ks = 0; ks < 2; ++ks) s[nt] = mfma16(lds8(X + (nt * 16 + fr) * 160 + ks * 64 + fq * 16), qf[ks], s[nt]);
        }
        const int iq = mt * 16 + fr;
        float mx = -3.0e38f;
#pragma unroll
        for (int nt = 0; nt < 16; ++nt)
#pragma unroll
            for (int i = 0; i < 4; ++i) { const int jk = nt * 16 + 4 * fq + i, rel = iq + 128 - jk; const bool valid = rel >= 0 && rel < 128 && (n > 0 || jk >= 128);
                s[nt][i] = valid ? s[nt][i] * 0.125f : -1e30f; mx = fmaxf(mx, s[nt][i]); }
        mx = fmaxf(mx, shx(mx, 16, lane)); mx = fmaxf(mx, shx(mx, 32, lane));
        mx = fmaxf(mx, sink);
        float sum = 0.f;
#pragma unroll
        for (int nt = 0; nt < 16; ++nt)
#pragma unroll
            for (int i = 0; i < 4; ++i) { s[nt][i] = __expf(s[nt][i] - mx); sum += s[nt][i]; }
        sum += shx(sum, 16, lane); sum += shx(sum, 32, lane);
        const float inv = 1.f / (sum + __expf(sink - mx));
#pragma unroll
        for (int nt = 0; nt < 16; ++nt) { u32x2 w; w.x = cvt_pk_bf16(s[nt][0] * inv, s[nt][1] * inv); w.y = cvt_pk_bf16(s[nt][2] * inv, s[nt][3] * inv);
            *(LAS u32x2*)(Pw + fr * 544 + (nt * 16 + 4 * fq) * 2) = w; }
        LDS_WAIT();
        f32x4 acc[4];
#pragma unroll
        for (int nt = 0; nt < 4; ++nt) acc[nt] = (f32x4){0.f, 0.f, 0.f, 0.f};
#pragma unroll
        for (int ks = 0; ks < 8; ++ks) {
            const bf16x8 pf = lds8(Pw + fr * 544 + ks * 64 + fq * 16);
#pragma unroll
            for (int nt = 0; nt < 4; ++nt) acc[nt] = mfma16(pf, lds8(Y + (nt * 16 + fr) * 544 + ks * 64 + fq * 16), acc[nt]);
        }
        LDS_WAIT();
#pragma unroll
        for (int nt = 0; nt < 4; ++nt)
#pragma unroll
            for (int i = 0; i < 4; ++i) *(LAS unsigned short*)(Pw + (4 * fq + i) * 160 + (nt * 16 + fr) * 2) = f2bf(acc[nt][i]);
        LDS_WAIT();
#pragma unroll
        for (int k = 0; k < 2; ++k) {
            const int c = lane + 64 * k, row = c >> 3, cc = c & 7;
            const u32x4 ov = *(const LAS u32x4*)(Pw + row * 160 + cc * 16);
            const size_t ro = (size_t)(tok0 + mt * 16 + row) * 6144 + hq * 64 + cc * 8;
            *(u32x4*)(Z + ro + 2048) = gate8(ov, gvs[k]);
        }
        LDS_WAIT();
    }
}

__device__ __forceinline__ void l2_flush_part(const float* base, size_t wg_bytes, int iters, int bid, int tid) {
    const u32x4* src = (const u32x4*)((const unsigned char*)base + (size_t)bid * wg_bytes) + tid;
    unsigned a = 0;
#pragma unroll 1
    for (int i0 = 0; i0 < iters; i0 += 8) {
        u32x4 v[8];
#pragma unroll
        for (int i = 0; i < 8; ++i) v[i] = src[(i0 + i) * 512];
#pragma unroll
        for (int i = 0; i < 8; ++i) a ^= v[i].x ^ v[i].y ^ v[i].z ^ v[i].w;
        asm volatile("s_waitcnt vmcnt(0)" ::: "memory");
#pragma unroll
        for (int i = 0; i < 8; ++i) a ^= (unsigned)__hip_atomic_load((const unsigned long long*)(src + (i0 + i) * 512), __ATOMIC_RELAXED, __HIP_MEMORY_SCOPE_AGENT);
    }
    asm volatile("" :: "v"(a));
}
__device__ __forceinline__ void l2_flush(const Params& p, int bid, int tid) {
    l2_flush_part(p.x, 262144, 32, bid, tid);
}

#define XB_TMO      128
#define XB_XCNT(j)  (256  + 64 * (j))
#define XB_XSUB(j)  (1280 + 64 * (j))
#define XB_XGEN(j)  (2304 + 64 * (j))
#define XB_TOP      3328
#define XB_TOPGEN   3392
#define XCD_BAR_WORDS 3456
#define XB_SPIN_CAP (1u << 18)
__device__ __forceinline__ unsigned xb_ld(unsigned* p)              { return __hip_atomic_load(p, __ATOMIC_RELAXED, __HIP_MEMORY_SCOPE_AGENT); }
__device__ __forceinline__ unsigned xb_add(unsigned* p, unsigned v) { return __hip_atomic_fetch_add(p, v, __ATOMIC_RELAXED, __HIP_MEMORY_SCOPE_AGENT); }
__device__ __forceinline__ unsigned xb_xcc_id() { return (unsigned)__builtin_amdgcn_s_getreg((3 << 11) | 20) & 0xFu; }
#define XB_SPIN(cond, bar) do { unsigned _sp = 0; while (cond) { __builtin_amdgcn_s_sleep(1); \
    if ((++_sp & 255u) == 0u) { if (xb_ld(&(bar)[XB_TMO])) break; if (_sp > XB_SPIN_CAP) { atomicAdd(&(bar)[XB_TMO], 1u); break; } } } } while (0)
struct XcdBarrier { unsigned* bar; unsigned x; volatile LAS unsigned* st; };
__device__ __forceinline__ void xcd_barrier_complete(unsigned* bar, unsigned x, unsigned& nloc, unsigned& nx) {
    const unsigned G = gridDim.x * gridDim.y * gridDim.z;
    unsigned sum, cnt, mine, sp = 0u;
    for (;;) {
        sum = 0u; cnt = 0u; mine = 0u;
#pragma unroll
        for (unsigned j = 0; j < 16; ++j) { const unsigned c = xb_ld(&bar[XB_XCNT(j)]); sum += c; cnt += (c > 0u) ? 1u : 0u; mine = (j == x) ? c : mine; }
        if (sum == G) break;
        __builtin_amdgcn_s_sleep(1);
        if ((++sp & 255u) == 0u) { if (xb_ld(&bar[XB_TMO])) break; if (sp > XB_SPIN_CAP) { atomicAdd(&bar[XB_TMO], 1u); break; } }
    }
    nloc = mine > 0u ? mine : 1u; nx = cnt > 0u ? cnt : 1u;
}
__device__ __forceinline__ void xcd_barrier(const XcdBarrier& b) {
    asm volatile("s_waitcnt vmcnt(0)" ::: "memory");
    __syncthreads();
    if (threadIdx.x == 0) {
        unsigned* bar = b.bar;
        __builtin_amdgcn_s_waitcnt(0);
        unsigned nloc = b.st[0], nx = b.st[1];
        if (nloc == 0u) { xcd_barrier_complete(bar, b.x, nloc, nx); b.st[0] = nloc; b.st[1] = nx; }
        const unsigned old = xb_add(&bar[XB_XSUB(b.x)], 1u);
        const unsigned gen = old / nloc;
        if (old + 1u == (gen + 1u) * nloc) {
            __builtin_amdgcn_fence(__ATOMIC_RELEASE, "agent");
            asm volatile("s_waitcnt vmcnt(0)" ::: "memory");
            const unsigned og = xb_add(&bar[XB_TOP], 1u);
            const unsigned tg = og / nx;
            if (og + 1u == (tg + 1u) * nx) xb_add(&bar[XB_TOPGEN], 1u);
            else XB_SPIN(xb_ld(&bar[XB_TOPGEN]) == tg, bar);
            __builtin_amdgcn_fence(__ATOMIC_ACQUIRE, "agent");
            xb_add(&bar[XB_XGEN(b.x)], 1u);
            asm volatile("s_waitcnt vmcnt(0)" ::: "memory");
        } else {
            XB_SPIN(xb_ld(&bar[XB_XGEN(b.x)]) == gen, bar);
            __builtin_amdgcn_fence(__ATOMIC_ACQUIRE, "agent");
            asm volatile("s_waitcnt vmcnt(0)" ::: "memory");
        }
    }
    __syncthreads();
}
__global__ void __launch_bounds__(NTHREADS, 2) yoco_fwd(Params p) {
    extern __shared__ __attribute__((aligned(16))) unsigned char lds_raw[];
    LAS unsigned char* lds = (LAS unsigned char*)lds_raw;
    const int tid = threadIdx.x, lane = tid & 63, wave = __builtin_amdgcn_readfirstlane(tid >> 6);
    const int G = gridDim.x, bid = blockIdx.x;
    const int lo = p.ph_lo, hi = p.ph_hi;
    int ph = 0;
    int xrank;
    XcdBarrier xbar;
    {
        LAS unsigned* slot = (LAS unsigned*)(lds + 147456);
        xbar.bar = (unsigned*)(p.ws + 16384); xbar.x = xb_xcc_id(); xbar.st = (volatile LAS unsigned*)(lds + 147456 + 16);
        if (tid == 0) { slot[0] = xb_add(&xbar.bar[XB_XCNT(xbar.x)], 1u); slot[4] = 0u; slot[5] = 0u; }
        __syncthreads();
        xrank = __builtin_amdgcn_readfirstlane((int)(slot[0] & 31u));
        __syncthreads();
    }
#define IN_PH() (ph >= lo && ph < hi)
#if MK_SINGLE
#define SEAM(FL) do { if (ph >= lo && ph + 1 < hi) { asm volatile("s_waitcnt vmcnt(0)" ::: "memory"); if (FL) { l2_flush(p, xrank, tid); asm volatile("s_waitcnt vmcnt(0)" ::: "memory"); } if (lo < 0) cg::this_grid().sync();     xcd_barrier(xbar); } ++ph; } while (0)
#else
#define SEAM(FL) do { ++ph; } while (0)
#endif
#define LOCAL_PTRS() int wz_ = 0; asm volatile("" : "+s"(wz_)); unsigned char* ws = p.ws + wz_; \
    bf16_t* YN = (bf16_t*)(ws + WS_YN); bf16_t* Z = (bf16_t*)(ws + WS_Z); bf16_t* WNAT = (bf16_t*)(ws + WS_WNAT); bf16_t* WSWP = (bf16_t*)(ws + WS_WSWP); bf16_t* WOUT = (bf16_t*)(ws + WS_WOUT); \
    (void)YN; (void)Z; (void)WNAT; (void)WSWP; (void)WOUT

    if (EN(0) && IN_PH()) phase_p0(p, lds, tid, wave, lane);
    SEAM(true);

    for (int l = 0; l < 4; ++l) {
        const bool isA = l < 2;
        if (IN_PH()) {
            LOCAL_PTRS();
            if (isA) {
                if (EN(1)) { pg8::Gemm g{YN, WNAT, T, 8192, D, D, D}; pg8::StaticOrder S; S.init(T, 8192, G, bid);
                  EpiNat E{Z, 8192, 16, (const f32x4*)(ws + WS_TABN), 0, -1, nullptr, nullptr};
                  pg8::gemm_phase<EpiNat, true>(lds, g, S, E); }
                if (EN(2)) { pg8::Gemm g{WSWP + (size_t)2048 * D, YN, 2048, T, D, D, D}; pg8::StaticOrder S; S.init(2048, T, G, bid);
                  EpiSwp E{(bf16_t*)(ws + WS_KVT) + (size_t)2048 * T, T, 0, nullptr, nullptr};
                  pg8::gemm_phase<EpiSwp, true>(lds, g, S, E); }
                if (EN(3) && l == 0) {
                    { pg8::Gemm g{(const bf16_t*)(ws + WS_MEMN), (const bf16_t*)(ws + WS_WMK), 1024, 4096, D, D, D}; pg8::StaticOrder S; S.init(1024, 4096, G, bid);
                      EpiNat E{(bf16_t*)(ws + WS_MK), 4096, 0, nullptr, 0, -1, nullptr, nullptr};
                      pg8::gemm_phase<EpiNat, true>(lds, g, S, E); }
                    { pg8::Gemm g{(const bf16_t*)(ws + WS_WMV), (const bf16_t*)(ws + WS_MEMN), 4096, 1024, D, D, D}; pg8::StaticOrder S; S.init(4096, 1024, G, (bid + 192) & 255);
                      EpiSwp E{(bf16_t*)(ws + WS_MVT), 1024, 0, nullptr, nullptr};
                      pg8::gemm_phase<EpiSwp, true>(lds, g, S, E); }
                }
            } else if (EN(4)) {
                const int N = (l == 2) ? 6400 : 6144;
                { pg8::Gemm g{YN, WNAT, T, N, D, D, D}; pg8::StaticOrder S; S.init(T, N, G, bid);
                  EpiNat E{Z, 6144, 0, nullptr, 8, (l == 2) ? 24 : -1, (bf16_t*)(ws + WS_KS), (const f32x4*)(ws + WS_SWAT)};
                  pg8::gemm_phase<EpiNat, true>(lds, g, S, E); }
                if (l == 2) {
                    pg8::Gemm g{WSWP, YN, 256, T, D, D, D}; pg8::StaticOrder S; S.init(256, T, G, (bid + 192) & 255);
                    EpiSwp E{(bf16_t*)(ws + WS_VST), T, 0, nullptr, nullptr};
                    pg8::gemm_phase<EpiSwp, true>(lds, g, S, E);
                }
            }
        }
        SEAM(true);
        if (isA) {
            if (IN_PH()) {
                LOCAL_PTRS();
                if (EN(5)) { __syncthreads(); for (int u = bid; u < 256; u += G) scan_unit(Z, (const bf16_t*)(ws + WS_KVT), (bf16_t*)(ws + WS_RT), lds, u, wave, lane); }
                if (EN(6)) for (int u = bid; u < 512; u += G) memattn_unit(p, l, u, 8192, 6144, lds, tid, wave, lane);
            }
            SEAM(true);
            if (EN(7) && IN_PH()) { for (int u = bid; u < 1024; u += G) retc_unit(p, u, lds, tid, wave, lane); }
            SEAM(false);
        } else {
            if (IN_PH()) {
                if (EN(8)) for (int u = bid; u < 512; u += G) swa_unit(p, l - 2, u, lds, tid, wave, lane);
                if (EN(6)) for (int u = bid; u < 512; u += G) memattn_unit(p, l, u, 6144, 4096, lds, tid, wave, lane);
            }
            SEAM(true);
        }
        if (EN(9) && IN_PH()) {
            LOCAL_PTRS();
            __syncthreads();
            pg8::StaticOrder S; S.init(T, D, G, bid);
            EpiNat E{(bf16_t*)(ws + WS_OUTF), D, 0, nullptr, 0, -1, nullptr, nullptr};
            if (isA) { pg8::Gemm g{Z + 4096, WOUT, T, D, 3072, 8192, 3072}; pg8::gemm_phase<EpiNat, true>(lds, g, S, E); }
            else     { pg8::Gemm g{Z + 2048, WOUT, T, D, 3072, 6144, 3072}; pg8::gemm_phase<EpiNat, true>(lds, g, S, E); }
        }
        SEAM(isA);
        if (EN(10) && IN_PH()) { __syncthreads(); phase_norm(p, l, lds, wave, lane); }
        SEAM(false);
    }
}
constexpr int N_PHASES = 1 + 2 * 5 + 2 * 4;
#ifndef PROBE_PH
#define PROBE_PH -1
#endif
#ifndef PROBE_OFF
#define PROBE_OFF WS_Z
#endif
__global__ void probe_copy(const bf16_t* src, float* out, size_t n) {
    for (size_t i = (size_t)blockIdx.x * blockDim.x + threadIdx.x; i < n; i += (size_t)gridDim.x * blockDim.x) out[i] = bf2f(src[i]);
}

extern "C" void kernel_launch(void* const* d_in, const int* in_sizes, int n_in, void* d_out, int out_size, void* d_ws, size_t ws_size, hipStream_t stream) {
    static int grid = 0;
    if (grid == 0) {
        if (n_in != 13 || ws_size < WS_END) { fprintf(stderr, "kernel_launch: unexpected n_in %d or ws_size %zu (< %zu)\n", n_in, ws_size, (size_t)WS_END); grid = -1; return; }
        if (hipFuncSetAttribute((const void*)yoco_fwd, hipFuncAttributeMaxDynamicSharedMemorySize, LDS_BYTES) != hipSuccess) { fprintf(stderr, "kernel_launch: hipFuncSetAttribute failed\n"); grid = -1; return; }
        int dev = 0, cus = 0, per_cu = 0;
        (void)hipGetDevice(&dev); (void)hipDeviceGetAttribute(&cus, hipDeviceAttributeMultiprocessorCount, dev);
        (void)hipOccupancyMaxActiveBlocksPerMultiprocessor(&per_cu, (const void*)yoco_fwd, NTHREADS, LDS_BYTES);
        if (per_cu < 1) { fprintf(stderr, "kernel_launch: occupancy query says %d blocks per CU\n", per_cu); per_cu = 1; }
        (void)hipGetLastError();
        grid = cus;
    }
    if (grid < 0) return;
    Params p{};
    p.x = (const float*)d_in[0]; p.mem = (const float*)d_in[1]; p.pos = (const int*)d_in[2]; p.pre_g = (const float*)d_in[3]; p.post_g = (const float*)d_in[4];
    p.mem_g = (const float*)d_in[5]; p.kv_g = (const float*)d_in[6]; p.w_in_a = (const float*)d_in[7]; p.w_in_b = (const float*)d_in[8]; p.w_kv_b = (const float*)d_in[9];
    p.sinks = (const float*)d_in[10]; p.w_mem_kv = (const float*)d_in[11]; p.w_out = (const float*)d_in[12];
    p.out = (float*)d_out; p.ws = (unsigned char*)d_ws;
    for (int j = 0; j < 128; ++j) p.inv_ret[j] = (float)pow(10000.0, -(double)(2 * j) / 256.0);
    for (int j = 0; j < 8; ++j) p.inv_swa[j] = (float)pow(500000.0, -(double)(2 * j) / 16.0);
#if MK_SINGLE
    p.ph_lo = 0; p.ph_hi = N_PHASES;
    (void)hipMemsetAsync(d_ws, 0, 32768, stream);
    void* args[] = {&p};
    hipError_t e = hipLaunchCooperativeKernel((const void*)yoco_fwd, dim3(grid), dim3(NTHREADS), args, LDS_BYTES, stream);
    if (e != hipSuccess) fprintf(stderr, "kernel_launch: cooperative launch failed: %s (grid %d)\n", hipGetErrorString(e), grid);
#else
    for (int ph = 0; ph < N_PHASES; ++ph) {
        p.ph_lo = ph; p.ph_hi = ph + 1;
        hipLaunchKernelGGL(yoco_fwd, dim3(grid), dim3(NTHREADS), LDS_BYTES, stream, p);
#ifdef SNAP_PH
        if (ph == SNAP_PH) (void)hipMemcpyAsync((unsigned char*)d_ws + 626 * MiB, (unsigned char*)d_ws + SNAP_OFF, 14 * MiB, hipMemcpyDeviceToDevice, stream);
#endif
#ifdef STOP_PH
        if (ph == STOP_PH) break;
#endif
#ifdef SNAP_PH
        if (ph == N_PHASES - 1) { (void)hipMemsetAsync(d_out, 0, (size_t)T * D * 4, stream);
            hipLaunchKernelGGL(probe_copy, dim3(2048), dim3(256), 0, stream, (const bf16_t*)((unsigned char*)d_ws + 626 * MiB), (float*)d_out, (size_t)7 * 1024 * 1024); }
#endif
        if (ph == PROBE_PH) { hipLaunchKernelGGL(probe_copy, dim3(2048), dim3(256), 0, stream, (const bf16_t*)((unsigned char*)d_ws + PROBE_OFF), (float*)d_out, (size_t)T * D); break; }
    }
#endif
}
```
